# Optimizing an MI355X kernel written in HIP

```python
import math
import jax
import jax.numpy as jnp
from jax import lax
import numpy as np

D_MODEL = 1024
BATCH = 8
SEQ = 2048
DEPTH = 2

HEAD_DIM = 64
BRANCH_WIDTH = D_MODEL // 4
N_HEADS = BRANCH_WIDTH // HEAD_DIM
N_BRANCHES = 5
DIFF_QK_DIM = HEAD_DIM // 2
DIL_PATTERNS = ((128, 1), (512, 4), (2048, 16))
S5_GROUP = 16
S5_GROUPS = BRANCH_WIDTH // S5_GROUP
S5_STATE = 64
S5_DT_MIN = 1e-3
S5_DT_MAX = 1e-1
CMP_BLOCK = 32
CMP_STRIDE = 16
CMP_HIDDEN = 256
SLC_BLOCK = 64
N_SELECT = 16
WINDOW = 512
MEM_LEN = 256
MEM_HEADS = 4
ROPE_THETA = 10000.0
Q_BLOCK = 128
G_BLOCK = 64
RMS_EPS = 1e-6
NEG_INF = -1e30
FORCE_SCORE = 1e9
IN_SIZES = (BRANCH_WIDTH, BRANCH_WIDTH, BRANCH_WIDTH, BRANCH_WIDTH,
            BRANCH_WIDTH, BRANCH_WIDTH, BRANCH_WIDTH, BRANCH_WIDTH,
            BRANCH_WIDTH, BRANCH_WIDTH,
            BRANCH_WIDTH, HEAD_DIM, HEAD_DIM, HEAD_DIM, HEAD_DIM, HEAD_DIM, HEAD_DIM,
            3 * N_HEADS, BRANCH_WIDTH,
            MEM_HEADS * HEAD_DIM, MEM_HEADS * HEAD_DIM)
IN_COLS = sum(IN_SIZES)

kernel_name = 'hybrid_gated_parallel_mixer'


def rmsnorm(x, g):
    x32 = x.astype(jnp.float32)
    y = x32 * lax.rsqrt(jnp.mean(x32 * x32, axis=-1, keepdims=True) + RMS_EPS)
    return (y * g.astype(jnp.float32)).astype(x.dtype)


def rope(x):
    s_len, half = x.shape[1], x.shape[-1] // 2
    inv_freq = ROPE_THETA ** (-jnp.arange(half, dtype=jnp.float32) / half)
    ang = jnp.arange(s_len, dtype=jnp.float32)[:, None] * inv_freq[None, :]
    shape = (1, s_len) + (1,) * (x.ndim - 3) + (half,)
    cos = jnp.cos(ang).reshape(shape)
    sin = jnp.sin(ang).reshape(shape)
    x32 = x.astype(jnp.float32)
    x1, x2 = x32[..., :half], x32[..., half:]
    return jnp.concatenate([x1 * cos - x2 * sin, x2 * cos + x1 * sin], axis=-1).astype(x.dtype)


def masked_softmax(s, mask):
    s = jnp.where(mask, s, NEG_INF)
    m = jnp.max(s, axis=-1, keepdims=True)
    e = jnp.where(mask, jnp.exp(s - m), 0.0)
    return e / jnp.maximum(jnp.sum(e, axis=-1, keepdims=True), 1e-30)


def to_blocks(a, blk):
    b, s_len = a.shape[0], a.shape[1]
    return jnp.moveaxis(a.reshape((b, s_len // blk, blk) + a.shape[2:]), 1, 0)


def from_blocks(o):
    o = jnp.moveaxis(o, 0, 1)
    return o.reshape((o.shape[0], o.shape[1] * o.shape[2]) + o.shape[3:])


def diff_attention(q, k, v, lam, lam_init, subln_g):
    s_len, dqk = q.shape[1], q.shape[-1]
    kpos = jnp.arange(s_len)
    v32 = v.astype(jnp.float32)

    def block(args):
        qi, bi = args
        qpos = bi * Q_BLOCK + jnp.arange(Q_BLOCK)
        mask = kpos[None, :] <= qpos[:, None]
        s = jnp.einsum('bqhcd,bkhcd->bhcqk', qi, k).astype(jnp.float32) * dqk ** -0.5
        p = masked_softmax(s, mask)
        a = p[:, :, 0] - lam * p[:, :, 1]
        return jnp.einsum('bhqk,bkhd->bqhd', a, v32)

    o = from_blocks(lax.map(block, (to_blocks(q, Q_BLOCK), jnp.arange(s_len // Q_BLOCK))))
    return rmsnorm(o, subln_g) * (1.0 - lam_init)


def dilated_attention(q, k, v):
    s_len, hd = q.shape[1], q.shape[-1]

    def block(args):
        qi, bi = args
        qpos = bi * G_BLOCK + jnp.arange(G_BLOCK)
        outs, lses = [], []
        for window, dil in DIL_PATTERNS:
            offs = np.arange(window // dil + 1) * dil
            kidx = qpos[:, None] - offs[None, :]
            valid = (kidx >= 0)[None, None]
            kidx = jnp.maximum(kidx, 0)
            kg = k[:, kidx]
            vg = v[:, kidx].astype(jnp.float32)
            s = jnp.einsum('bqhd,bqkhd->bhqk', qi, kg).astype(jnp.float32) * hd ** -0.5
            s = jnp.where(valid, s, NEG_INF)
            m = jnp.max(s, axis=-1, keepdims=True)
            e = jnp.where(valid, jnp.exp(s - m), 0.0)
            den = jnp.sum(e, axis=-1, keepdims=True)
            outs.append(jnp.einsum('bhqk,bqkhd->bhqd', e, vg) / den)
            lses.append(m + jnp.log(den))
        w = jax.nn.softmax(jnp.stack(lses, 0), axis=0)
        o = jnp.sum(w * jnp.stack(outs, 0), axis=0)
        return jnp.swapaxes(o, 1, 2)

    return from_blocks(lax.map(block, (to_blocks(q, G_BLOCK), jnp.arange(s_len // G_BLOCK))))


def ssm_combine(e1, e2):
    a1r, a1i, b1r, b1i = e1
    a2r, a2i, b2r, b2i = e2
    return (a2r * a1r - a2i * a1i,
            a2r * a1i + a2i * a1r,
            a2r * b1r - a2i * b1i + b2r,
            a2r * b1i + a2i * b1r + b2i)


def s5_branch(u, lam_re, lam_im, log_dt, b_re, b_im, c_re, c_im, d_skip, w_glu, b_glu):
    bsz, s_len = u.shape[0], u.shape[1]
    f32 = jnp.float32
    u = u.astype(f32).reshape(bsz, s_len, S5_GROUPS, S5_GROUP)
    lr, li = lam_re.astype(f32), lam_im.astype(f32)
    dt = jnp.exp(log_dt.astype(f32))[:, None]
    mag = jnp.exp(lr * dt)
    a_re, a_im = mag * jnp.cos(li * dt), mag * jnp.sin(li * dt)
    den = lr * lr + li * li
    n_re, n_im = a_re - 1.0, a_im
    z_re = (n_re * lr + n_im * li) / den
    z_im = (n_im * lr - n_re * li) / den
    br, bi = b_re.astype(f32), b_im.astype(f32)
    bb_re = z_re[..., None] * br - z_im[..., None] * bi
    bb_im = z_re[..., None] * bi + z_im[..., None] * br
    bu_re = jnp.einsum('gnp,bsgp->bsgn', bb_re, u)
    bu_im = jnp.einsum('gnp,bsgp->bsgn', bb_im, u)
    a_re_t = jnp.broadcast_to(a_re, bu_re.shape)
    a_im_t = jnp.broadcast_to(a_im, bu_im.shape)
    _, _, x_re, x_im = lax.associative_scan(ssm_combine, (a_re_t, a_im_t, bu_re, bu_im), axis=1)
    y = (jnp.einsum('gpn,bsgn->bsgp', c_re.astype(f32), x_re)
         - jnp.einsum('gpn,bsgn->bsgp', c_im.astype(f32), x_im)
         + d_skip.astype(f32) * u)
    y = y.reshape(bsz, s_len, BRANCH_WIDTH)
    t = jax.nn.gelu(y) @ w_glu.astype(f32) + b_glu.astype(f32)
    return t[..., :BRANCH_WIDTH] * jax.nn.sigmoid(t[..., BRANCH_WIDTH:])


def nsa_attention(q, kc, vc, ks, vs, kw, vw, gates, pe, w1, w2):
    bsz, s_len, _, hd = q.shape
    f32 = jnp.float32
    scale = hd ** -0.5
    pos = jnp.arange(s_len)

    n_cmp = (s_len - CMP_BLOCK) // CMP_STRIDE + 1
    cidx = np.arange(n_cmp)[:, None] * CMP_STRIDE + np.arange(CMP_BLOCK)[None, :]

    def compress(t, pe_i, w1_i, w2_i):
        blk = t[:, cidx] + pe_i
        return jax.nn.gelu(blk.reshape(bsz, n_cmp, CMP_BLOCK * hd) @ w1_i) @ w2_i

    k_cmp = compress(kc, pe[0], w1[0], w2[0])
    v_cmp = compress(vc, pe[1], w1[1], w2[1]).astype(f32)
    cmask = cidx[:, -1][None, :] <= pos[:, None]
    p_cmp = masked_softmax(jnp.einsum('bshd,bnd->bhsn', q, k_cmp).astype(f32) * scale, cmask)
    o_cmp = jnp.einsum('bhsn,bnd->bshd', p_cmp, v_cmp)

    n_slc = s_len // SLC_BLOCK
    n_sel = min(N_SELECT, n_slc)
    c0 = np.arange(n_cmp)[:, None] * CMP_STRIDE
    s0 = np.arange(n_slc)[None, :] * SLC_BLOCK
    overlap = np.clip(np.minimum(c0 + CMP_BLOCK, s0 + SLC_BLOCK) - np.maximum(c0, s0), 0, None) / CMP_STRIDE
    importance = jnp.einsum('bhsn,nj->bsj', p_cmp, jnp.asarray(overlap, dtype=f32))
    qblk = (pos // SLC_BLOCK)[:, None]
    blk = jnp.arange(n_slc)[None, :]
    forced = (blk == 0) | (blk == qblk) | (blk == qblk - 1)
    score = jnp.where(blk <= qblk, jnp.where(forced, FORCE_SCORE, importance), NEG_INF)
    top_val, top_idx = lax.top_k(score, n_sel)
    top_ok = top_val > 0.5 * NEG_INF

    q_r = rope(q)
    ks_r = rope(ks)
    kw_r = rope(kw)
    vs32 = vs.astype(f32)
    gather = jax.vmap(lambda tb, ib: tb[ib])

    def sel_block(args):
        qi, ti, oki, bi = args
        qpos = bi * G_BLOCK + jnp.arange(G_BLOCK)
        tok = (ti[..., None] * SLC_BLOCK + jnp.arange(SLC_BLOCK)).reshape(bsz, G_BLOCK, n_sel * SLC_BLOCK)
        valid = jnp.repeat(oki, SLC_BLOCK, axis=-1) & (tok <= qpos[None, :, None])
        kg = gather(ks_r, tok)
        vg = gather(vs32, tok)
        s = jnp.einsum('bqhd,bqtd->bhqt', qi, kg).astype(f32) * scale
        p = masked_softmax(s, valid[:, None])
        return jnp.einsum('bhqt,bqtd->bqhd', p, vg)

    o_slc = from_blocks(lax.map(sel_block, (to_blocks(q_r, G_BLOCK), to_blocks(top_idx, G_BLOCK),
                                            to_blocks(top_ok, G_BLOCK), jnp.arange(s_len // G_BLOCK))))

    kp = jnp.pad(kw_r, ((0, 0), (WINDOW, 0), (0, 0)))
    vp = jnp.pad(vw.astype(f32), ((0, 0), (WINDOW, 0), (0, 0)))

    def win_block(args):
        qi, bi = args
        start = bi * Q_BLOCK
        kb = lax.dynamic_slice_in_dim(kp, start, Q_BLOCK + WINDOW, axis=1)
        vb = lax.dynamic_slice_in_dim(vp, start, Q_BLOCK + WINDOW, axis=1)
        kpos = start - WINDOW + jnp.arange(Q_BLOCK + WINDOW)
        dist = (start + jnp.arange(Q_BLOCK))[:, None] - kpos[None, :]
        mask = (dist >= 0) & (dist < WINDOW) & (kpos[None, :] >= 0)
        s = jnp.einsum('bqhd,bkd->bhqk', qi, kb).astype(f32) * scale
        p = masked_softmax(s, mask)
        return jnp.einsum('bhqk,bkd->bqhd', p, vb)

    o_win = from_blocks(lax.map(win_block, (to_blocks(q_r, Q_BLOCK), jnp.arange(s_len // Q_BLOCK))))

    g = jax.nn.sigmoid(gates.astype(f32))
    return g[..., 0:1] * o_cmp + g[..., 1:2] * o_slc + g[..., 2:3] * o_win


def memory_attention(q, mem, g, w_kv):
    bsz, m_len = mem.shape[0], mem.shape[1]
    width = MEM_HEADS * HEAD_DIM
    kv = rmsnorm(mem, g) @ w_kv
    k = kv[..., :width].reshape(bsz, m_len, MEM_HEADS, HEAD_DIM)
    v = kv[..., width:].reshape(bsz, m_len, MEM_HEADS, HEAD_DIM).astype(jnp.float32)
    s = jnp.einsum('bshd,bmhd->bhsm', q, k).astype(jnp.float32) * HEAD_DIM ** -0.5
    p = jax.nn.softmax(s, axis=-1)
    return jnp.einsum('bhsm,bmhd->bshd', p, v)


def setup_inputs(seed: int = 0) -> dict:
    key = jax.random.key(seed)
    ks = jax.random.split(key, 26)

    def nrm(k, shape, scale):
        return scale * jax.random.normal(k, shape, jnp.float32)

    n_ids = jnp.arange(S5_STATE, dtype=jnp.float32)
    s5_shape = (DEPTH, S5_GROUPS, S5_STATE)
    return {
        'x': nrm(ks[0], (BATCH, SEQ, D_MODEL), 1.0),
        'mem': nrm(ks[1], (BATCH, MEM_LEN, D_MODEL), 1.0),
        'norm_g': 1.0 + nrm(ks[2], (DEPTH, D_MODEL), 0.02),
        'w_in': nrm(ks[3], (DEPTH, D_MODEL, IN_COLS), D_MODEL ** -0.5),
        'diff_lambda': nrm(ks[4], (DEPTH, 4, DIFF_QK_DIM), 0.1),
        'diff_subln_g': 1.0 + nrm(ks[5], (DEPTH, HEAD_DIM), 0.02),
        's5_lambda_re': -0.5 + nrm(ks[6], s5_shape, 0.01),
        's5_lambda_im': math.pi * n_ids + nrm(ks[7], s5_shape, 0.01),
        's5_log_dt': jax.random.uniform(ks[8], (DEPTH, S5_GROUPS), jnp.float32,
                                        math.log(S5_DT_MIN), math.log(S5_DT_MAX)),
        's5_b_re': nrm(ks[9], (DEPTH, S5_GROUPS, S5_STATE, S5_GROUP), (2 * S5_GROUP) ** -0.5),
        's5_b_im': nrm(ks[10], (DEPTH, S5_GROUPS, S5_STATE, S5_GROUP), (2 * S5_GROUP) ** -0.5),
        's5_c_re': nrm(ks[11], (DEPTH, S5_GROUPS, S5_GROUP, S5_STATE), S5_STATE ** -0.5),
        's5_c_im': nrm(ks[12], (DEPTH, S5_GROUPS, S5_GROUP, S5_STATE), S5_STATE ** -0.5),
        's5_d': nrm(ks[13], (DEPTH, S5_GROUPS, S5_GROUP), 1.0),
        'w_glu': nrm(ks[14], (DEPTH, BRANCH_WIDTH, 2 * BRANCH_WIDTH), BRANCH_WIDTH ** -0.5),
        'b_glu': nrm(ks[15], (DEPTH, 2 * BRANCH_WIDTH), 0.01),
        'nsa_pe': nrm(ks[16], (DEPTH, 2, CMP_BLOCK, HEAD_DIM), 0.02),
        'nsa_w1': nrm(ks[17], (DEPTH, 2, CMP_BLOCK * HEAD_DIM, CMP_HIDDEN), (CMP_BLOCK * HEAD_DIM) ** -0.5),
        'nsa_w2': nrm(ks[18], (DEPTH, 2, CMP_HIDDEN, HEAD_DIM), CMP_HIDDEN ** -0.5),
        'mem_norm_g': 1.0 + nrm(ks[19], (DEPTH, D_MODEL), 0.02),
        'w_mem_kv': nrm(ks[20], (DEPTH, D_MODEL, 2 * MEM_HEADS * HEAD_DIM), D_MODEL ** -0.5),
        'w_merge': nrm(ks[21], (DEPTH, D_MODEL, N_BRANCHES * D_MODEL), D_MODEL ** -0.5),
        'b_merge': nrm(ks[22], (DEPTH, N_BRANCHES * D_MODEL), 0.01),
        'w_branch': nrm(ks[23], (DEPTH, N_BRANCHES, BRANCH_WIDTH, D_MODEL), BRANCH_WIDTH ** -0.5),
        'w_out': nrm(ks[24], (DEPTH, D_MODEL, D_MODEL), D_MODEL ** -0.5),
        'final_g': 1.0 + nrm(ks[25], (D_MODEL,), 0.02),
    }


def reference(x, mem, norm_g, w_in, diff_lambda, diff_subln_g, s5_lambda_re, s5_lambda_im,
              s5_log_dt, s5_b_re, s5_b_im, s5_c_re, s5_c_im, s5_d, w_glu, b_glu, nsa_pe,
              nsa_w1, nsa_w2, mem_norm_g, w_mem_kv, w_merge, b_merge, w_branch, w_out, final_g):
    bsz, s_len = x.shape[0], x.shape[1]
    splits = np.cumsum(np.array(IN_SIZES))[:-1].tolist()
    for l in range(DEPTH):
        h = rmsnorm(x, norm_g[l])
        proj = h @ w_in[l]
        (a_q, a_k, a_v, a_z, b_q, b_k, b_v, b_z, c_u, c_z,
         d_q, d_kc, d_vc, d_ks, d_vs, d_kw, d_vw, d_g, d_z, e_q, e_z) = jnp.split(proj, splits, axis=-1)

        qa = rope(a_q.reshape(bsz, s_len, N_HEADS, 2, DIFF_QK_DIM))
        ka = rope(a_k.reshape(bsz, s_len, N_HEADS, 2, DIFF_QK_DIM))
        va = a_v.reshape(bsz, s_len, N_HEADS, HEAD_DIM)
        dl = diff_lambda[l].astype(jnp.float32)
        lam_init = 0.8 - 0.6 * math.exp(-0.3 * l)
        lam = jnp.exp(jnp.sum(dl[0] * dl[1])) - jnp.exp(jnp.sum(dl[2] * dl[3])) + lam_init
        o_a = diff_attention(qa, ka, va, lam, lam_init, diff_subln_g[l]).reshape(bsz, s_len, BRANCH_WIDTH)

        qb = rope(b_q.reshape(bsz, s_len, N_HEADS, HEAD_DIM))
        kb = rope(b_k.reshape(bsz, s_len, N_HEADS, HEAD_DIM))
        vb = b_v.reshape(bsz, s_len, N_HEADS, HEAD_DIM)
        o_b = dilated_attention(qb, kb, vb).reshape(bsz, s_len, BRANCH_WIDTH)

        o_c = s5_branch(c_u, s5_lambda_re[l], s5_lambda_im[l], s5_log_dt[l], s5_b_re[l], s5_b_im[l],
                        s5_c_re[l], s5_c_im[l], s5_d[l], w_glu[l], b_glu[l])

        o_d = nsa_attention(d_q.reshape(bsz, s_len, N_HEADS, HEAD_DIM), d_kc, d_vc, d_ks, d_vs, d_kw, d_vw,
                            d_g.reshape(bsz, s_len, N_HEADS, 3), nsa_pe[l], nsa_w1[l], nsa_w2[l])
        o_d = o_d.reshape(bsz, s_len, BRANCH_WIDTH)

        o_e = memory_attention(e_q.reshape(bsz, s_len, MEM_HEADS, HEAD_DIM), mem, mem_norm_g[l], w_mem_kv[l])
        o_e = o_e.reshape(bsz, s_len, MEM_HEADS * HEAD_DIM)

        branches = jnp.stack([o_a * jax.nn.silu(a_z), o_b * jax.nn.silu(b_z), o_c * jax.nn.silu(c_z),
                              o_d * jax.nn.silu(d_z), o_e * jax.nn.silu(e_z)], axis=2)
        y = jnp.einsum('bsnc,ncd->bsnd', branches, w_branch[l])
        gate = jax.nn.sigmoid(h @ w_merge[l] + b_merge[l]).reshape(bsz, s_len, N_BRANCHES, D_MODEL)
        mixed = jnp.einsum('bsnd,bsnd->bsd', gate, y)
        x = x + (mixed @ w_out[l]).astype(x.dtype)
    return rmsnorm(x, final_g)
```

```cpp
#include <hip/hip_runtime.h>
#include <hip/hip_bf16.h>
#include <hip/hip_cooperative_groups.h>
#include <cstdio>
namespace cg = cooperative_groups;

typedef unsigned short u16;
typedef __attribute__((ext_vector_type(8))) short bf16x8;
typedef __attribute__((ext_vector_type(4))) short bf16x4;
typedef __attribute__((ext_vector_type(4))) float f32x4;
typedef __attribute__((ext_vector_type(4))) unsigned u32x4;

constexpr int T = 16384, S = 2048;
constexpr int NSA_NQT = 2;
#ifndef PMASK
#define PMASK 255
#endif
#define PON(rep, bit) ((rep) == 0 || ((PMASK) & (bit)))

struct P {
  const float *x, *mem, *norm_g, *w_in, *diff_lambda, *diff_subln_g, *s5_lre, *s5_lim, *s5_logdt, *s5_bre, *s5_bim,
      *s5_cre, *s5_cim, *s5_d, *w_glu, *b_glu, *nsa_pe, *nsa_w1, *nsa_w2, *mem_norm_g, *w_mem_kv, *w_merge, *b_merge,
      *w_branch, *w_out, *final_g;
  float* out;
  char* ws;
};

constexpr size_t SZ_WCAT = (size_t)4096 * 1024 * 2;
constexpr size_t SZ_WM8 = (size_t)5120 * 1024;
constexpr size_t SZ_WBT = (size_t)5 * 1024 * 256 * 2;
constexpr size_t SZ_WOT = (size_t)1024 * 1024 * 2;
constexpr size_t SZ_WGT = (size_t)512 * 256 * 2;
constexpr size_t SZ_WKVT = (size_t)512 * 1024 * 2;
constexpr size_t SZ_W1T = (size_t)2 * 256 * 2048 * 2;
constexpr size_t SZ_W2T = (size_t)2 * 128 * 256 * 2;
constexpr size_t SZ_HEADBUF = (size_t)8 * 4 * 2048 * 64 * 2;
constexpr size_t SZ_ONEBUF = (size_t)8 * 2048 * 64 * 2 + 8192;
constexpr size_t O_WCAT = 0;
constexpr size_t O_WBT = O_WCAT + 2 * SZ_WCAT;
constexpr size_t O_WOT = O_WBT + 2 * SZ_WBT;
constexpr size_t O_WGT = O_WOT + 2 * SZ_WOT;
constexpr size_t O_WKVT = O_WGT + 2 * SZ_WGT;
constexpr size_t O_W1T = O_WKVT + 2 * SZ_WKVT;
constexpr size_t O_W2T = O_W1T + 2 * SZ_W1T;
constexpr size_t O_H = O_W2T + 2 * SZ_W2T;
constexpr size_t O_SZ = O_H + (size_t)T * 1024 * 2;
constexpr size_t O_DQ = O_SZ + (size_t)5 * T * 256 * 2;
constexpr size_t O_DK = O_DQ + SZ_HEADBUF;
constexpr size_t O_DV = O_DK + SZ_HEADBUF;
constexpr size_t O_LQ = O_DV + SZ_HEADBUF;
constexpr size_t O_LK = O_LQ + SZ_HEADBUF;
constexpr size_t O_LV = O_LK + SZ_HEADBUF;
constexpr size_t O_NQ = O_LV + SZ_HEADBUF;
constexpr size_t O_MQ = O_NQ + SZ_HEADBUF;
constexpr size_t O_KC = O_MQ + SZ_HEADBUF;
constexpr size_t O_VC = O_KC + SZ_ONEBUF;
constexpr size_t O_KSR = O_VC + SZ_ONEBUF;
constexpr size_t O_VS = O_KSR + SZ_ONEBUF;
constexpr size_t O_KWR = O_VS + SZ_ONEBUF;
constexpr size_t O_VW = O_KWR + SZ_ONEBUF;
constexpr size_t O_SU = O_VW + SZ_ONEBUF;
constexpr size_t O_MEMH = O_SU + (size_t)T * 256 * 4;
constexpr size_t O_MEMK = O_MEMH + (size_t)2 * 2048 * 1024 * 2;
constexpr size_t O_MEMV = O_MEMK + (size_t)2 * 8 * 4 * 256 * 64 * 2;
constexpr size_t O_CHID = O_MEMV + (size_t)2 * 8 * 4 * 256 * 64 * 2;
constexpr size_t O_KCMP = O_CHID + (size_t)2 * 1024 * 256 * 2;
constexpr size_t O_VCMP = O_KCMP + (size_t)8 * 128 * 64 * 2;
constexpr size_t O_NG = O_VCMP + (size_t)8 * 128 * 64 * 2;
constexpr size_t O_DLSE = O_NG + (size_t)T * 12 * 4;
constexpr size_t O_S5E = O_DLSE + (size_t)3 * T * 4 * 4;
constexpr size_t O_S5P = O_S5E + (size_t)8 * 16 * 32 * 64 * 8;
constexpr size_t SZ_S5P = (size_t)(4096 + 32768) * 4;
constexpr size_t O_BPE = O_S5P + 2 * SZ_S5P;
constexpr size_t O_ROPE32 = O_BPE + (size_t)2 * 2 * 16 * 256 * 4;
constexpr size_t O_ROPE16 = O_ROPE32 + (size_t)2048 * 32 * 8;
constexpr size_t O_LAM = O_ROPE16 + (size_t)2048 * 16 * 8;
constexpr size_t O_CTR = O_LAM + 256;
constexpr size_t O_BAR = O_CTR + 256;
constexpr size_t O_WM8 = O_BAR + 16384;
constexpr size_t O_H8 = O_WM8 + 2 * SZ_WM8;
constexpr size_t WS_NEED = O_H8 + (size_t)T * 1024;
constexpr size_t O_DILO = O_DQ;
constexpr size_t O_MIXED = O_LQ;
constexpr size_t O_YG = O_MEMH;

typedef const __attribute__((address_space(4))) P* PP;
#define WSP(type, off) ((type*)(p->ws + (off)))
__device__ __forceinline__ int ltid() {
  int t = threadIdx.x;
  asm volatile("" : "+v"(t));
  return t;
}
__device__ __forceinline__ float shfx(float v, int mask, int lane) {
  return __int_as_float(__builtin_amdgcn_ds_bpermute((lane ^ mask) << 2, __float_as_int(v)));
}
typedef unsigned u32x2_t __attribute__((ext_vector_type(2)));
__device__ __forceinline__ float xmax16(float v) { u32x2_t r = __builtin_amdgcn_permlane16_swap(__float_as_uint(v), __float_as_uint(v), false, false); return fmaxf(__uint_as_float(r[0]), __uint_as_float(r[1])); }
__device__ __forceinline__ float xmax32(float v) { u32x2_t r = __builtin_amdgcn_permlane32_swap(__float_as_uint(v), __float_as_uint(v), false, false); return fmaxf(__uint_as_float(r[0]), __uint_as_float(r[1])); }
__device__ __forceinline__ float xsum16(float v) { u32x2_t r = __builtin_amdgcn_permlane16_swap(__float_as_uint(v), __float_as_uint(v), false, false); return __uint_as_float(r[0]) + __uint_as_float(r[1]); }
__device__ __forceinline__ float xsum32(float v) { u32x2_t r = __builtin_amdgcn_permlane32_swap(__float_as_uint(v), __float_as_uint(v), false, false); return __uint_as_float(r[0]) + __uint_as_float(r[1]); }
__device__ __forceinline__ PP getP() {
  PP k = (PP)__builtin_amdgcn_kernarg_segment_ptr();
  asm volatile("" : "+s"(k));
  return k;
}

typedef __bf16 bf16x2_t __attribute__((ext_vector_type(2)));
typedef float f32x2_t __attribute__((ext_vector_type(2)));
__device__ __forceinline__ u16 f2bf(float f) { return __builtin_bit_cast(u16, (__bf16)f); }
__device__ __forceinline__ float bf2f(u16 b) { return __uint_as_float(((unsigned)b) << 16); }
__device__ __forceinline__ unsigned pack2(float a, float b) { f32x2_t v = {a, b}; return __builtin_bit_cast(unsigned, __builtin_convertvector(v, bf16x2_t)); }
__device__ __forceinline__ float fexp(float x) { return __builtin_amdgcn_exp2f(x * 1.4426950408889634f); }
__device__ __forceinline__ float sigm(float x) { return __builtin_amdgcn_rcpf(1.f + fexp(-x)); }
__device__ __forceinline__ float silu(float x) { return x * __builtin_amdgcn_rcpf(1.f + fexp(-x)); }
__device__ __forceinline__ float gelu(float x) {
  float u = 0.7978845608028654f * (x + 0.044715f * x * x * x);
  float e = fexp(2.f * u);
  float th = 1.f - 2.f * __builtin_amdgcn_rcpf(e + 1.f);
  return 0.5f * x * (1.f + th);
}
typedef long i64x2 __attribute__((ext_vector_type(2)));
__device__ __forceinline__ unsigned pack4_fp8(float a, float b, float c, float d) {
  int r = __builtin_amdgcn_cvt_pk_fp8_f32(a, b, 0, false);
  r = __builtin_amdgcn_cvt_pk_fp8_f32(c, d, r, true);
  return (unsigned)r;
}
__device__ __forceinline__ f32x4 mfma16(bf16x8 a, bf16x8 b, f32x4 c) {
  return __builtin_amdgcn_mfma_f32_16x16x32_bf16(a, b, c, 0, 0, 0);
}
__device__ __forceinline__ int fetch_item(unsigned* ctr, int* sh) {
  __syncthreads();
  if (ltid() == 0) *sh = (int)atomicAdd(ctr, 1u);
  __syncthreads();
  return *sh;
}

constexpr int STG = 32768;
#define WAIT_V(n) asm volatile("s_waitcnt vmcnt(" #n ")" ::: "memory")
#define RAW_BARRIER() do { asm volatile("s_waitcnt lgkmcnt(0)" ::: "memory"); __builtin_amdgcn_s_barrier(); asm volatile("" ::: "memory"); } while (0)
__device__ __forceinline__ void glds16(const u16* g, char* l) {
  __builtin_amdgcn_global_load_lds((const unsigned*)g, (unsigned*)l, 16, 0, 0);
}
template <bool FP8 = false>
__device__ __forceinline__ void gemm_core(f32x4 (&acc)[4][4], const u16* __restrict__ A, long lda,
                                          const u16* __restrict__ Bt, long ldb, int K, u16* smem) {
  const int tid = ltid(), lane = tid & 63, wave = tid >> 6, wr = wave >> 1, wc = wave & 1;
  const int lr = lane & 15, lq = lane >> 4;
  char* base = (char*)smem;
  const int row0 = tid >> 3, kcs = ((tid & 7) ^ ((row0 >> 1) & 7)) * 8;
  const unsigned voA = (unsigned)(row0 * (int)lda + kcs) * 2u, voB = (unsigned)(row0 * (int)ldb + kcs) * 2u;
  const char* Ab = (const char*)A;
  const char* Bb = (const char*)Bt;
  const long a32 = 64 * lda, b32 = 64 * ldb;
  char* dst0 = base + wave * 1024;
  const int f = (lr >> 1) & 7;
  const int aoff = (wr * 64 + lr) * 128, boff = 16384 + (wc * 64 + lr) * 128;
  const int sw0 = ((lq) ^ f) * 16, sw1 = ((4 + lq) ^ f) * 16;
  const int nk = FP8 ? (K >> 7) : (K >> 6);
  RAW_BARRIER();
  {
    char* d = dst0;
#pragma unroll
    for (int i = 0; i < 4; ++i) { glds16((const u16*)(Ab + i * a32 + voA), d + i * 4096); glds16((const u16*)(Bb + i * b32 + voB), d + 16384 + i * 4096); }
    Ab += 128; Bb += 128;
  }
  for (int kt = 0; kt < nk; ++kt) {
    const int cur = kt & 1;
    WAIT_V(0);
    RAW_BARRIER();
    if (kt + 1 < nk) {
      char* d = dst0 + (cur ^ 1) * STG;
#pragma unroll
      for (int i = 0; i < 4; ++i) { glds16((const u16*)(Ab + i * a32 + voA), d + i * 4096); glds16((const u16*)(Bb + i * b32 + voB), d + 16384 + i * 4096); }
      Ab += 128; Bb += 128;
    }
    const char* cs = base + cur * STG;
    if (FP8) {
      typedef int i32x8 __attribute__((ext_vector_type(8)));
      i32x8 a8[4], b8[4];
#pragma unroll
      for (int i = 0; i < 4; ++i) {
        u32x4 al = *(const u32x4*)(cs + aoff + i * 2048 + sw0), ah = *(const u32x4*)(cs + aoff + i * 2048 + sw1);
        u32x4 bl = *(const u32x4*)(cs + boff + i * 2048 + sw0), bh = *(const u32x4*)(cs + boff + i * 2048 + sw1);
        a8[i] = i32x8{(int)al.x, (int)al.y, (int)al.z, (int)al.w, (int)ah.x, (int)ah.y, (int)ah.z, (int)ah.w};
        b8[i] = i32x8{(int)bl.x, (int)bl.y, (int)bl.z, (int)bl.w, (int)bh.x, (int)bh.y, (int)bh.z, (int)bh.w};
      }
#pragma unroll
      for (int mi = 0; mi < 4; ++mi)
#pragma unroll
        for (int ni = 0; ni < 4; ++ni)
          acc[mi][ni] = __builtin_amdgcn_mfma_scale_f32_16x16x128_f8f6f4(a8[mi], b8[ni], acc[mi][ni], 0, 0, 0, 0x7F7F7F7F, 0, 0x7F7F7F7F);
    } else {
#pragma unroll
      for (int ks = 0; ks < 2; ++ks) {
        const int sw = ks ? sw1 : sw0;
        bf16x8 af[4], bf[4];
#pragma unroll
        for (int i = 0; i < 4; ++i) { af[i] = *(const bf16x8*)(cs + aoff + i * 2048 + sw); bf[i] = *(const bf16x8*)(cs + boff + i * 2048 + sw); }
#pragma unroll
        for (int mi = 0; mi < 4; ++mi)
#pragma unroll
          for (int ni = 0; ni < 4; ++ni) acc[mi][ni] = mfma16(af[mi], bf[ni], acc[mi][ni]);
      }
    }
  }
  RAW_BARRIER();
}

template <int FN>
__device__ __forceinline__ void store_tile_bf16(const f32x4 (&acc)[4][4], u16* dst, long ld, u16* smem) {
  const int tid = ltid(), lane = tid & 63, wave = tid >> 6, lr = lane & 15, lq = lane >> 4;
  u16* patch = smem + wave * (64 * 72);
#pragma unroll
  for (int mi = 0; mi < 4; ++mi)
#pragma unroll
    for (int j = 0; j < 4; ++j)
#pragma unroll
      for (int ni = 0; ni < 4; ++ni) {
        float v = acc[mi][ni][j];
        if (FN == 1) v = silu(v);
        if (FN == 2) v = gelu(v);
        patch[(mi * 16 + lq * 4 + j) * 72 + ni * 16 + lr] = f2bf(v);
      }
  __builtin_amdgcn_wave_barrier();
#pragma unroll
  for (int i = 0; i < 8; ++i) {
    const int row = i * 8 + (lane >> 3), ch = (lane & 7) * 8;
    u32x4 v = *(const u32x4*)(patch + row * 72 + ch);
    *(u32x4*)(dst + (long)row * ld + ch) = v;
  }
  __builtin_amdgcn_wave_barrier();
}
__device__ __forceinline__ void store_tile_f32(const f32x4 (&acc)[4][4], float* dst, const float* add, long ld, u16* smem) {
  const int tid = ltid(), lane = tid & 63, wave = tid >> 6, lr = lane & 15, lq = lane >> 4;
  float* patch = (float*)smem + wave * (32 * 68);
#pragma unroll
  for (int hf = 0; hf < 2; ++hf) {
#pragma unroll
    for (int m2 = 0; m2 < 2; ++m2)
#pragma unroll
      for (int j = 0; j < 4; ++j)
#pragma unroll
        for (int ni = 0; ni < 4; ++ni) patch[(m2 * 16 + lq * 4 + j) * 68 + ni * 16 + lr] = acc[hf * 2 + m2][ni][j];
    __builtin_amdgcn_wave_barrier();
#pragma unroll
    for (int i = 0; i < 8; ++i) {
      const int row = i * 4 + (lane >> 4), c4 = (lane & 15) * 4;
      f32x4 v = *(const f32x4*)(patch + row * 68 + c4);
      const long o = (long)(hf * 32 + row) * ld + c4;
      if (add) v += *(const f32x4*)(add + o);
      *(f32x4*)(dst + o) = v;
    }
    __builtin_amdgcn_wave_barrier();
  }
}

constexpr int ALD = 80;
constexpr int ALDK = 80;
template <int NQT, int NS>
struct ASt {
  f32x4 o[NS][4][NQT];
  float m[NS][NQT], l[NS][NQT];
  bf16x8 q[NQT][2];
  __device__ __forceinline__ void reset() {
#pragma unroll
    for (int c = 0; c < NS; ++c)
#pragma unroll
      for (int qi = 0; qi < NQT; ++qi) {
        m[c][qi] = -1e30f; l[c][qi] = 0.f;
#pragma unroll
        for (int di = 0; di < 4; ++di) o[c][di][qi] = f32x4{0.f, 0.f, 0.f, 0.f};
      }
  }
};
struct KVsrc { const u16* k; const u16* v; long ld; };

struct KVregs { u32x4 v0, v1; };
constexpr int KBUF = 8192;
__device__ __forceinline__ void k_dma(const KVsrc& s, int kb, char* kbuf) {
  const int tid = ltid(), wave = tid >> 6;
  const int row = tid >> 3, kcs = ((tid & 7) ^ ((row >> 1) & 7)) * 8;
  __builtin_amdgcn_global_load_lds((const unsigned*)(s.k + (long)(kb + row) * s.ld + kcs), (unsigned*)(kbuf + wave * 1024), 16, 0, 0);
  __builtin_amdgcn_global_load_lds((const unsigned*)(s.k + (long)(kb + row + 32) * s.ld + kcs), (unsigned*)(kbuf + 4096 + wave * 1024), 16, 0, 0);
}
__device__ __forceinline__ void kv_load(const KVsrc& s, int kb, KVregs& R) {
  const int tid = ltid();
  const int row = tid >> 3, col8 = (tid & 7) * 8;
  R.v0 = *(const u32x4*)(s.v + (long)(kb + row) * s.ld + col8);
  R.v1 = *(const u32x4*)(s.v + (long)(kb + row + 32) * s.ld + col8);
}
__device__ __forceinline__ void kv_store(u16* svt, const KVregs& R) {
  const int tid = ltid();
  const int row = tid >> 3, col8 = (tid & 7) * 8;
  *(u32x4*)(svt + row * ALD + col8) = R.v0;
  *(u32x4*)(svt + (row + 32) * ALD + col8) = R.v1;
}

template <int NQT, int NS, bool MASKED, class MaskF>
__device__ __forceinline__ void attn_step(ASt<NQT, NS>& st, const char* sk, const u16* svt, int kb, float c2, MaskF mask) {
  const int lane = ltid() & 63, lr = lane & 15, lq = lane >> 4;
#pragma unroll
  for (int c = 0; c < NS; ++c) {
    f32x4 s[4][NQT];
#pragma unroll
    for (int ki = 0; ki < 4; ++ki) {
      const char* kp = sk + (ki * 16 + lr) * 128;
      const int kf = (lr >> 1) & 7;
      bf16x8 k0 = *(const bf16x8*)(kp + ((((NS == 2 ? 4 * c : 0) + lq) ^ kf) << 4));
      bf16x8 k1 = k0;
      if (NS == 1) k1 = *(const bf16x8*)(kp + (((4 + lq) ^ kf) << 4));
#pragma unroll
      for (int qi = 0; qi < NQT; ++qi) {
        f32x4 z = {0.f, 0.f, 0.f, 0.f};
        z = mfma16(k0, st.q[qi][NS == 1 ? 0 : c], z);
        if (NS == 1) z = mfma16(k1, st.q[qi][1], z);
        s[ki][qi] = z;
      }
    }
    bf16x8 pb[NQT][2];
#pragma unroll
    for (int qi = 0; qi < NQT; ++qi) {
      float mx = st.m[c][qi];
#pragma unroll
      for (int ki = 0; ki < 4; ++ki)
#pragma unroll
        for (int j = 0; j < 4; ++j) {
          float sv = s[ki][qi][j];
          if (MASKED) { sv = mask(kb + ki * 16 + lq * 4 + j, qi) ? sv : -INFINITY; s[ki][qi][j] = sv; }
          mx = fmaxf(mx, sv);
        }
      mx = xmax32(xmax16(mx));
      const float alpha = __builtin_amdgcn_exp2f((st.m[c][qi] - mx) * c2);
      st.m[c][qi] = mx;
      const float mneg = -mx * c2;
      float ls = 0.f;
#pragma unroll
      for (int ki = 0; ki < 4; ++ki)
#pragma unroll
        for (int j = 0; j < 4; ++j) {
          float pv = __builtin_amdgcn_exp2f(__builtin_fmaf(s[ki][qi][j], c2, mneg));
          ls += pv;
          s[ki][qi][j] = pv;
        }
      st.l[c][qi] = st.l[c][qi] * alpha + ls;
#pragma unroll
      for (int di = 0; di < 4; ++di) st.o[c][di][qi] *= alpha;
#pragma unroll
      for (int kk = 0; kk < 2; ++kk) {
        union { unsigned u[4]; bf16x8 v; } pk;
        pk.u[0] = pack2(s[2 * kk][qi][0], s[2 * kk][qi][1]);
        pk.u[1] = pack2(s[2 * kk][qi][2], s[2 * kk][qi][3]);
        pk.u[2] = pack2(s[2 * kk + 1][qi][0], s[2 * kk + 1][qi][1]);
        pk.u[3] = pack2(s[2 * kk + 1][qi][2], s[2 * kk + 1][qi][3]);
        pb[qi][kk] = pk.v;
      }
    }
#pragma unroll
    for (int di = 0; di < 4; ++di)
#pragma unroll
      for (int kk = 0; kk < 2; ++kk) {
        const u16* vp = svt + (kk * 32 + lq * 4 + (lr >> 2)) * ALD + di * 16 + (lr & 3) * 4;
        union { bf16x4 h[2]; bf16x8 v; } vf;
        vf.h[0] = __builtin_amdgcn_ds_read_tr16_b64_v4i16((__attribute__((address_space(3))) bf16x4*)vp);
        vf.h[1] = __builtin_amdgcn_ds_read_tr16_b64_v4i16((__attribute__((address_space(3))) bf16x4*)(vp + 16 * ALD));
#pragma unroll
        for (int qi = 0; qi < NQT; ++qi) st.o[c][di][qi] = mfma16(vf.v, pb[qi][kk], st.o[c][di][qi]);
      }
  }
}

template <int NQT, int NS, class MaskF, class NeedF, class MNeedF>
__device__ __forceinline__ void attn_pass(ASt<NQT, NS>& st, KVsrc src, int kt0, int kt1, float scale, u16* smem, MaskF mask, NeedF need, MNeedF mneed) {
  if (kt0 >= kt1) return;
  const float c2 = scale * 1.4426950408889634f;
  char* sk = (char*)smem;
  u16* svt = smem + KBUF;
  KVregs R;
  __syncthreads();
  k_dma(src, kt0 * 64, sk);
  kv_load(src, kt0 * 64, R);
  kv_store(svt, R);
  asm volatile("s_waitcnt vmcnt(0)" ::: "memory");
  __syncthreads();
  for (int kt = kt0; kt < kt1; ++kt) {
    const int cur = (kt - kt0) & 1;
    const bool more = kt + 1 < kt1;
    if (more) { k_dma(src, (kt + 1) * 64, sk + (cur ^ 1) * KBUF); kv_load(src, (kt + 1) * 64, R); }
    if (need(kt)) {
      if (mneed(kt)) attn_step<NQT, NS, true>(st, sk + cur * KBUF, svt + cur * 64 * ALD, kt * 64, c2, mask);
      else attn_step<NQT, NS, false>(st, sk + cur * KBUF, svt + cur * 64 * ALD, kt * 64, c2, mask);
    }
    if (more) kv_store(svt + (cur ^ 1) * 64 * ALD, R);
    asm volatile("s_waitcnt vmcnt(0)" ::: "memory");
    __syncthreads();
  }
}
__device__ __forceinline__ float quadsum_(float v, int lane) { return xsum32(xsum16(v)); }
#define quadsum(v) quadsum_((v), lane)

__device__ __forceinline__ int remap_row(int kind, int n) {
  if (kind == 1) return n < 3200 ? n : (n < 3212 ? 3968 + (n - 3200) : n - 12);
  if (kind == 2) { int c = n & 255, g = n >> 8; return 32 * (c >> 4) + 16 * g + (c & 15); }
  return n;
}
struct XTile { const float* src; u16* dst; int N, Kd, remap, k0, n0; bool f8; };
__device__ __forceinline__ void xpose_load(const XTile& t, f32x4 (&v)[4]) {
  const int tid = ltid();
#pragma unroll
  for (int i = 0; i < 4; ++i) {
    int kk = (tid >> 4) + i * 16, nn = (tid & 15) * 4;
    int n = t.n0 + nn;
    v[i] = f32x4{0.f, 0.f, 0.f, 0.f};
    if (n < t.N) v[i] = *(const f32x4*)(t.src + (long)(t.k0 + kk) * t.N + n);
  }
}
__device__ __forceinline__ void xpose_finish(const XTile& t, const f32x4 (&v)[4], float* tile) {
  const int tid = ltid();
  __syncthreads();
#pragma unroll
  for (int i = 0; i < 4; ++i) {
    int kk = (tid >> 4) + i * 16, nn = (tid & 15) * 4;
    tile[kk * 65 + nn] = v[i][0]; tile[kk * 65 + nn + 1] = v[i][1]; tile[kk * 65 + nn + 2] = v[i][2]; tile[kk * 65 + nn + 3] = v[i][3];
  }
  __syncthreads();
  int nn = tid >> 2, ks = (tid & 3) * 16;
  int n = t.n0 + nn;
  if (n < t.N) {
    int drow = remap_row(t.remap, n);
    if (t.f8) {
      unsigned w8[4];
#pragma unroll
      for (int i = 0; i < 4; ++i)
        w8[i] = pack4_fp8(32.f * tile[(ks + 4 * i) * 65 + nn], 32.f * tile[(ks + 4 * i + 1) * 65 + nn], 32.f * tile[(ks + 4 * i + 2) * 65 + nn], 32.f * tile[(ks + 4 * i + 3) * 65 + nn]);
      *(uint4*)((char*)t.dst + (long)drow * t.Kd + t.k0 + ks) = uint4{w8[0], w8[1], w8[2], w8[3]};
    } else {
      unsigned w[8];
#pragma unroll
      for (int i = 0; i < 8; ++i) w[i] = pack2(tile[(ks + 2 * i) * 65 + nn], tile[(ks + 2 * i + 1) * 65 + nn]);
      u16* d = t.dst + (long)drow * t.Kd + t.k0 + ks;
      *(uint4*)d = uint4{w[0], w[1], w[2], w[3]};
      *(uint4*)(d + 8) = uint4{w[4], w[5], w[6], w[7]};
    }
  }
}

template <bool OUT_BF16>
__device__ __forceinline__ void rmsnorm_row(const float* src, const float* g, void* dst, unsigned char* dst8 = nullptr) {
  const int lane = ltid() & 63;
  float4 v[4];
  float ss = 0.f;
#pragma unroll
  for (int k = 0; k < 4; ++k) {
    v[k] = *(const float4*)(src + k * 256 + lane * 4);
    ss += v[k].x * v[k].x + v[k].y * v[k].y + v[k].z * v[k].z + v[k].w * v[k].w;
  }
  ss += __int_as_float(__builtin_amdgcn_update_dpp(0, __float_as_int(ss), 0xB1, 0xf, 0xf, true));
  ss += __int_as_float(__builtin_amdgcn_update_dpp(0, __float_as_int(ss), 0x4E, 0xf, 0xf, true));
  ss += __int_as_float(__builtin_amdgcn_update_dpp(0, __float_as_int(ss), 0x141, 0xf, 0xf, true));
  ss += __int_as_float(__builtin_amdgcn_update_dpp(0, __float_as_int(ss), 0x140, 0xf, 0xf, true));
  ss = xsum32(xsum16(ss));
  float rs = rsqrtf(ss * (1.f / 1024.f) + 1e-6f);
#pragma unroll
  for (int k = 0; k < 4; ++k) {
    float4 gg = *(const float4*)(g + k * 256 + lane * 4);
    float a = v[k].x * rs * gg.x, b = v[k].y * rs * gg.y, c = v[k].z * rs * gg.z, d = v[k].w * rs * gg.w;
    if (OUT_BF16) {
      uint2 o2; o2.x = pack2(a, b); o2.y = pack2(c, d);
      *(uint2*)((u16*)dst + k * 256 + lane * 4) = o2;
      if (dst8) *(unsigned*)(dst8 + k * 256 + lane * 4) = pack4_fp8(a, b, c, d);
    } else {
      *(float4*)((float*)dst + k * 256 + lane * 4) = float4{a, b, c, d};
    }
  }
}

__device__ void phase_setup(PP p, char* smem) {
  const int tid = ltid(), lane = tid & 63, wave = tid >> 6;
  const long gtid = (long)blockIdx.x * 256 + tid, gsz = (long)gridDim.x * 256;
  float* tile = (float*)smem;
  if ((int)blockIdx.x >= (int)gridDim.x - 64) {
    const int it = blockIdx.x - (gridDim.x - 64);
    const int lk = it >> 4, kc = it & 15;
    const float* pe = p->nsa_pe + (long)lk * 2048 + kc * 128 + wave * 32;
    const float* w1 = p->nsa_w1 + ((long)lk * 2048 + kc * 128 + wave * 32) * 256 + lane;
    float s0 = 0.f, s1 = 0.f, s2 = 0.f, s3 = 0.f;
#pragma unroll 8
    for (int k = 0; k < 32; ++k) {
      float pv = pe[k];
      s0 += pv * w1[(long)k * 256]; s1 += pv * w1[(long)k * 256 + 64]; s2 += pv * w1[(long)k * 256 + 128]; s3 += pv * w1[(long)k * 256 + 192];
    }
    tile[wave * 256 + lane] = s0; tile[wave * 256 + 64 + lane] = s1; tile[wave * 256 + 128 + lane] = s2; tile[wave * 256 + 192 + lane] = s3;
    __syncthreads();
    WSP(float, O_BPE)[(lk * 16 + kc) * 256 + tid] = tile[tid] + tile[256 + tid] + tile[512 + tid] + tile[768 + tid];
    __syncthreads();
  }
  {
    auto decode = [&](int it, XTile& t) {
      int l = it / 3288, r = it % 3288;
      int nt; t.remap = 0; t.f8 = false;
      if (r < 1008) { t.src = p->w_in + (long)l * 1024 * 3980; t.N = 3980; t.Kd = 1024; t.dst = WSP(u16, O_WCAT + l * SZ_WCAT); t.remap = 1; nt = 63; }
      else if ((r -= 1008) < 1280) { t.src = p->w_merge + (long)l * 1024 * 5120; t.N = 5120; t.Kd = 1024; t.dst = (u16*)(p->ws + O_WM8 + l * SZ_WM8); t.f8 = true; nt = 80; }
      else if ((r -= 1280) < 320) { int n = r / 64; r %= 64; t.src = p->w_branch + (long)(l * 5 + n) * 256 * 1024; t.N = 1024; t.Kd = 256; t.dst = WSP(u16, O_WBT + l * SZ_WBT) + (long)n * 1024 * 256; nt = 16; }
      else if ((r -= 320) < 256) { t.src = p->w_out + (long)l * 1024 * 1024; t.N = 1024; t.Kd = 1024; t.dst = WSP(u16, O_WOT + l * SZ_WOT); nt = 16; }
      else if ((r -= 256) < 32) { t.src = p->w_glu + (long)l * 256 * 512; t.N = 512; t.Kd = 256; t.dst = WSP(u16, O_WGT + l * SZ_WGT); t.remap = 2; nt = 8; }
      else if ((r -= 32) < 128) { t.src = p->w_mem_kv + (long)l * 1024 * 512; t.N = 512; t.Kd = 1024; t.dst = WSP(u16, O_WKVT + l * SZ_WKVT); nt = 8; }
      else if ((r -= 128) < 256) { int kv = r / 128; r %= 128; t.src = p->nsa_w1 + (long)(l * 2 + kv) * 2048 * 256; t.N = 256; t.Kd = 2048; t.dst = WSP(u16, O_W1T + l * SZ_W1T) + (long)kv * 256 * 2048; nt = 4; }
      else { r -= 256; int kv = r / 4; r %= 4; t.src = p->nsa_w2 + (long)(l * 2 + kv) * 256 * 64; t.N = 64; t.Kd = 256; t.dst = WSP(u16, O_W2T + l * SZ_W2T) + (long)kv * 128 * 256; nt = 1; }
      t.k0 = (r / nt) * 64; t.n0 = (r % nt) * 64;
    };
    XTile tc, tn;
    f32x4 vc[4], vn[4];
    int it = blockIdx.x;
    if (it < 6576) { decode(it, tc); xpose_load(tc, vc); }
    for (; it < 6576; it += gridDim.x) {
      const int nx = it + gridDim.x;
      if (nx < 6576) { decode(nx, tn); xpose_load(tn, vn); }
      xpose_finish(tc, vc, tile);
      tc = tn;
#pragma unroll
      for (int i = 0; i < 4; ++i) vc[i] = vn[i];
    }
  }
  for (long i = gtid; i < 2 * 116 * 1024; i += gsz) { int l = (int)(i / (116 * 1024)); long r = i % (116 * 1024); WSP(u16, O_WCAT + l * SZ_WCAT)[(long)3980 * 1024 + r] = 0; }
  for (long i = gtid; i < 4 * 64 * 256; i += gsz) { int lk = (int)(i / (64 * 256)); long r = i % (64 * 256); WSP(u16, O_W2T)[(long)lk * 128 * 256 + 64 * 256 + r] = 0; }
  for (long i = gtid; i < 4096; i += gsz) { WSP(u16, O_KC)[(long)8 * 2048 * 64 + i] = 0; WSP(u16, O_VC)[(long)8 * 2048 * 64 + i] = 0; }
  if (gtid < 64) WSP(unsigned, O_CTR)[gtid] = 0u;
  for (int r0 = blockIdx.x * 4 + wave; r0 < T + 4096; r0 += gridDim.x * 8) {
#pragma unroll
    for (int u = 0; u < 2; ++u) {
      const int r = r0 + u * (int)gridDim.x * 4;
      if (r < T) rmsnorm_row<true>(p->x + (long)r * 1024, p->norm_g, WSP(u16, O_H) + (long)r * 1024, (unsigned char*)(p->ws + O_H8) + (long)r * 1024);
      else if (r < T + 4096) { int rr = r - T; int l = rr >> 11; int m = rr & 2047; rmsnorm_row<true>(p->mem + (long)m * 1024, p->mem_norm_g + l * 1024, WSP(u16, O_MEMH) + (long)rr * 1024); }
    }
  }
  for (long i = gtid; i < 2048 * 48; i += gsz) {
    int s = (int)(i / 48), e = (int)(i % 48);
    float fr = e < 32 ? (float)e / 32.f : (float)(e - 32) / 16.f;
    float inv = exp2f(-fr * 13.287712379549449f);
    float ang = (float)s * inv;
    float sn, cs; sincosf(ang, &sn, &cs);
    if (e < 32) WSP(float2, O_ROPE32)[s * 32 + e] = float2{cs, sn};
    else WSP(float2, O_ROPE16)[s * 16 + (e - 32)] = float2{cs, sn};
  }
  for (long i = gtid; i < 2048; i += gsz) {
    int l = (int)(i >> 10), gn = (int)(i & 1023), g = gn >> 6;
    float lr = p->s5_lre[i], li = p->s5_lim[i];
    float dt = expf(p->s5_logdt[l * 16 + g]);
    float mag = expf(lr * dt);
    float sn, cs; sincosf(li * dt, &sn, &cs);
    float are = mag * cs, aim = mag * sn;
    float den = lr * lr + li * li;
    float nre = are - 1.f, nim = aim;
    float zre = (nre * lr + nim * li) / den, zim = (nim * lr - nre * li) / den;
    float* sp = WSP(float, O_S5P + l * SZ_S5P);
    sp[gn] = are; sp[1024 + gn] = aim;
    float magL = expf(lr * dt * 64.f);
    float snL, csL; sincosf(li * dt * 64.f, &snL, &csL);
    sp[2048 + gn] = magL * csL; sp[3072 + gn] = magL * snL;
    for (int q = 0; q < 16; ++q) {
      float br = p->s5_bre[i * 16 + q], bi = p->s5_bim[i * 16 + q];
      sp[4096 + gn * 16 + q] = zre * br - zim * bi;
      sp[4096 + 16384 + gn * 16 + q] = zre * bi + zim * br;
    }
  }
  if (gtid < 2) {
    int l = (int)gtid;
    const float* dl = p->diff_lambda + l * 128;
    float s1 = 0.f, s2 = 0.f;
    for (int i = 0; i < 32; ++i) { s1 += dl[i] * dl[32 + i]; s2 += dl[64 + i] * dl[96 + i]; }
    float li = 0.8f - 0.6f * expf(-0.3f * (float)l);
    WSP(float, O_LAM)[l * 2] = expf(s1) - expf(s2) + li;
    WSP(float, O_LAM)[l * 2 + 1] = li;
  }
}

__device__ __forceinline__ void epi_proj(PP p, f32x4 (&acc)[4][4], int trow0, int tcol0, u16* smem) {
  const int lane = ltid() & 63, wave = ltid() >> 6, wr = wave >> 1, wc = wave & 1, lr = lane & 15, lq = lane >> 4;
  const int row0 = trow0 + wr * 64, cc = (tcol0 + wc * 64) >> 6;
  const int b = row0 >> 11, s0 = row0 & 2047;
  int kind = 0; u16* dst = nullptr; long ld = 64;
  auto headbuf = [&](size_t off, int h) { dst = WSP(u16, off) + ((long)((b * 4 + h) * 2048 + s0)) * 64; ld = 64; };
  auto onebuf = [&](size_t off) { dst = WSP(u16, off) + ((long)(b * 2048 + s0)) * 64; ld = 64; };
  auto szbuf = [&](int n, int h) { dst = WSP(u16, O_SZ) + (long)n * T * 256 + (long)row0 * 256 + h * 64; ld = 256; kind = 3; };
  if (cc < 4) { kind = 1; headbuf(O_DQ, cc); }
  else if (cc < 8) { kind = 1; headbuf(O_DK, cc - 4); }
  else if (cc < 12) { headbuf(O_DV, cc - 8); }
  else if (cc < 16) { szbuf(0, cc - 12); }
  else if (cc < 20) { kind = 2; headbuf(O_LQ, cc - 16); }
  else if (cc < 24) { kind = 2; headbuf(O_LK, cc - 20); }
  else if (cc < 28) { headbuf(O_LV, cc - 24); }
  else if (cc < 32) { szbuf(1, cc - 28); }
  else if (cc < 36) { kind = 4; }
  else if (cc < 40) { szbuf(2, cc - 36); }
  else if (cc < 44) { headbuf(O_NQ, cc - 40); }
  else if (cc == 44) { onebuf(O_KC); }
  else if (cc == 45) { onebuf(O_VC); }
  else if (cc == 46) { kind = 2; onebuf(O_KSR); }
  else if (cc == 47) { onebuf(O_VS); }
  else if (cc == 48) { kind = 2; onebuf(O_KWR); }
  else if (cc == 49) { onebuf(O_VW); }
  else if (cc < 54) { szbuf(3, cc - 50); }
  else if (cc < 58) { headbuf(O_MQ, cc - 54); }
  else if (cc < 62) { szbuf(4, cc - 58); }
  else if (cc == 62) { kind = 5; }
  else { kind = 6; }
  if (kind == 6) return;
  if (kind == 4) {
    float* su = WSP(float, O_SU) + (long)row0 * 256 + (cc - 32) * 64;
    store_tile_f32(acc, su, nullptr, 256, smem);
    return;
  }
  if (kind == 5) {
    float* ng = WSP(float, O_NG) + (long)row0 * 12;
    if (lr < 12) {
#pragma unroll
      for (int mi = 0; mi < 4; ++mi)
#pragma unroll
        for (int j = 0; j < 4; ++j) ng[(mi * 16 + lq * 4 + j) * 12 + lr] = sigm(acc[mi][0][j]);
    }
    return;
  }
  if (kind == 3) { store_tile_bf16<1>(acc, dst, ld, smem); return; }
  if (kind == 1) {
    const float2* tab = WSP(float2, O_ROPE16);
#pragma unroll
    for (int mi = 0; mi < 4; ++mi)
#pragma unroll
      for (int j = 0; j < 4; ++j) {
        float2 cs = tab[(s0 + mi * 16 + lq * 4 + j) * 16 + lr];
#pragma unroll
        for (int ni = 0; ni < 4; ni += 2) {
          float x1 = acc[mi][ni][j], x2 = acc[mi][ni + 1][j];
          acc[mi][ni][j] = x1 * cs.x - x2 * cs.y;
          acc[mi][ni + 1][j] = x2 * cs.x + x1 * cs.y;
        }
      }
  } else if (kind == 2) {
    const float2* tab = WSP(float2, O_ROPE32);
#pragma unroll
    for (int mi = 0; mi < 4; ++mi)
#pragma unroll
      for (int j = 0; j < 4; ++j)
#pragma unroll
        for (int ni = 0; ni < 2; ++ni) {
          float2 cs = tab[(s0 + mi * 16 + lq * 4 + j) * 32 + ni * 16 + lr];
          float x1 = acc[mi][ni][j], x2 = acc[mi][ni + 2][j];
          acc[mi][ni][j] = x1 * cs.x - x2 * cs.y;
          acc[mi][ni + 2][j] = x2 * cs.x + x1 * cs.y;
        }
  }
  store_tile_bf16<0>(acc, dst, ld, smem);
}

__device__ void phase_gemm1(PP p, int l, u16* smem) {
  const int wave = ltid() >> 6, wr = wave >> 1, wc = wave & 1;
  const int ntile = 4096;
  for (int t = blockIdx.x; t < ntile; t += gridDim.x) {
    p = getP();
    f32x4 acc[4][4];
#pragma unroll
    for (int i = 0; i < 4; ++i)
#pragma unroll
      for (int j = 0; j < 4; ++j) acc[i][j] = f32x4{0.f, 0.f, 0.f, 0.f};
    {
      int rt, ct;
      if (gridDim.x == 512) { const int xcd = t & 7, slot = (t >> 3) & 63, rnd = t >> 9; rt = rnd * 16 + ((xcd >> 2) << 3) + (slot >> 3); ct = ((xcd & 3) << 3) + (slot & 7); }
      else { rt = t >> 5; ct = t & 31; }
      gemm_core(acc, WSP(u16, O_H) + (long)rt * 128 * 1024, 1024, WSP(u16, O_WCAT + l * SZ_WCAT) + (long)ct * 128 * 1024, 1024, 1024, smem);
      epi_proj(p, acc, rt * 128, ct * 128, smem);
    }
  }
}

__device__ void item_diff(PP p, int l, int id, u16* smem, bool g_dry) {
  const int lane = ltid() & 63, wave = ltid() >> 6, lr = lane & 15, lq = lane >> 4;
  const int qb = 31 - (id >> 5), bh = id & 31, h = bh & 3, b = bh >> 2;
  const int s = qb * 64 + wave * 16 + lr;
  ASt<1, 2> st;
  st.reset();
  const u16* qp = WSP(u16, O_DQ) + ((long)(bh * 2048 + s)) * 64 + lq * 8;
  st.q[0][0] = *(const bf16x8*)qp;
  st.q[0][1] = *(const bf16x8*)(qp + 32);
  KVsrc src{WSP(u16, O_DK) + (long)bh * 2048 * 64, WSP(u16, O_DV) + (long)bh * 2048 * 64, 64};
  attn_pass<1, 2>(st, src, 0, qb + 1, 0.17677669529663687f, smem, [&](int key, int qi) { return key <= s; }, [&](int kt) { return true; }, [&](int kt) { return kt == qb; });
  const float lam = WSP(float, O_LAM)[l * 2], lam_init = WSP(float, O_LAM)[l * 2 + 1];
  float i0 = 1.f / quadsum(st.l[0][0]), i1 = lam / quadsum(st.l[1][0]);
  float ss = 0.f;
#pragma unroll
  for (int di = 0; di < 4; ++di)
#pragma unroll
    for (int j = 0; j < 4; ++j) {
      float v = st.o[0][di][0][j] * i0 - st.o[1][di][0][j] * i1;
      st.o[0][di][0][j] = v;
      ss += v * v;
    }
  ss = quadsum(ss);
  float rs = rsqrtf(ss * (1.f / 64.f) + 1e-6f) * (1.f - lam_init);
  u16* zb = WSP(u16, O_SZ) + ((long)(b * 2048 + s)) * 256 + h * 64;
#pragma unroll
  for (int di = 0; di < 4; ++di) {
    int d0 = di * 16 + lq * 4;
    uint2 zz = *(const uint2*)(zb + d0);
    float4 g = *(const float4*)(p->diff_subln_g + l * 64 + d0);
    float o0 = st.o[0][di][0][0] * rs * g.x * bf2f((u16)(zz.x & 0xffff));
    float o1 = st.o[0][di][0][1] * rs * g.y * bf2f((u16)(zz.x >> 16));
    float o2 = st.o[0][di][0][2] * rs * g.z * bf2f((u16)(zz.y & 0xffff));
    float o3 = st.o[0][di][0][3] * rs * g.w * bf2f((u16)(zz.y >> 16));
    uint2 ov; ov.x = pack2(o0, o1); ov.y = pack2(o2, o3);
    if (!g_dry) *(uint2*)(zb + d0) = ov;
  }
}

__device__ void item_dilated(PP p, int id, u16* smem) {
  const int lane = ltid() & 63, wave = ltid() >> 6, lr = lane & 15, lq = lane >> 4;
  const int pat = id >> 9; int r = id & 511;
  const int dil = pat == 0 ? 1 : (pat == 1 ? 4 : 16);
  const int nblk = 16 / dil;
  const int blk = r % nblk; r /= nblk;
  const int res = r % dil; r /= dil;
  const int bh = r;
  const int b = bh >> 2, h = bh & 3;
  int qi_idx[2], spos[2];
#pragma unroll
  for (int qi = 0; qi < 2; ++qi) { qi_idx[qi] = blk * 128 + wave * 32 + qi * 16 + lr; spos[qi] = qi_idx[qi] * dil + res; }
  ASt<2, 1> st;
  st.reset();
#pragma unroll
  for (int qi = 0; qi < 2; ++qi) {
    const u16* qp = WSP(u16, O_LQ) + ((long)(bh * 2048 + spos[qi])) * 64 + lq * 8;
    st.q[qi][0] = *(const bf16x8*)qp;
    st.q[qi][1] = *(const bf16x8*)(qp + 32);
  }
  KVsrc src{WSP(u16, O_LK) + ((long)(bh * 2048 + res)) * 64, WSP(u16, O_LV) + ((long)(bh * 2048 + res)) * 64, (long)dil * 64};
  const int kt0 = blk * 2 - 2 < 0 ? 0 : blk * 2 - 2, kt1 = blk * 2 + 2;
  const int imin = blk * 128 + wave * 32, imax = imin + 31;
  attn_pass<2, 1>(st, src, kt0, kt1, 0.125f, smem,
                  [&](int key, int qi) { return key <= qi_idx[qi] && key >= qi_idx[qi] - 128; },
                  [&](int kt) { return kt * 64 <= imax && kt * 64 + 63 >= imin - 128; },
                  [&](int kt) { return !(kt * 64 + 63 <= imin && kt * 64 >= imax - 128); });
#pragma unroll
  for (int qi = 0; qi < 2; ++qi) {
    float lt = quadsum(st.l[0][qi]);
    float inv = 1.f / lt;
    long tok = (long)b * 2048 + spos[qi];
    u16* ob = WSP(u16, O_DILO) + (long)pat * T * 256 + tok * 256 + h * 64;
#pragma unroll
    for (int di = 0; di < 4; ++di) {
      uint2 ov; ov.x = pack2(st.o[0][di][qi][0] * inv, st.o[0][di][qi][1] * inv); ov.y = pack2(st.o[0][di][qi][2] * inv, st.o[0][di][qi][3] * inv);
      *(uint2*)(ob + di * 16 + lq * 4) = ov;
    }
    if (lq == 0) WSP(float, O_DLSE)[(long)pat * T * 4 + tok * 4 + h] = st.m[0][qi] * 0.125f + __logf(lt);
  }
}

__device__ void item_mem(PP p, int l, int id, u16* smem, bool g_dry) {
  const int lane = ltid() & 63, wave = ltid() >> 6, lr = lane & 15, lq = lane >> 4;
  const int qb = id & 15, bh = id >> 4, b = bh >> 2, h = bh & 3;
  int spos[2];
  ASt<2, 1> st;
  st.reset();
#pragma unroll
  for (int qi = 0; qi < 2; ++qi) {
    spos[qi] = qb * 128 + wave * 32 + qi * 16 + lr;
    const u16* qp = WSP(u16, O_MQ) + ((long)(bh * 2048 + spos[qi])) * 64 + lq * 8;
    st.q[qi][0] = *(const bf16x8*)qp;
    st.q[qi][1] = *(const bf16x8*)(qp + 32);
  }
  KVsrc src{WSP(u16, O_MEMK) + (long)l * 8 * 4 * 256 * 64 + (long)bh * 256 * 64, WSP(u16, O_MEMV) + (long)l * 8 * 4 * 256 * 64 + (long)bh * 256 * 64, 64};
  attn_pass<2, 1>(st, src, 0, 4, 0.125f, smem, [&](int key, int qi) { return true; }, [&](int kt) { return true; }, [&](int kt) { return false; });
#pragma unroll
  for (int qi = 0; qi < 2; ++qi) {
    float inv = 1.f / quadsum(st.l[0][qi]);
    u16* zb = WSP(u16, O_SZ) + (long)4 * T * 256 + ((long)(b * 2048 + spos[qi])) * 256 + h * 64;
#pragma unroll
    for (int di = 0; di < 4; ++di) {
      int d0 = di * 16 + lq * 4;
      uint2 zz = *(const uint2*)(zb + d0);
      uint2 ov;
      ov.x = pack2(st.o[0][di][qi][0] * inv * bf2f((u16)(zz.x & 0xffff)), st.o[0][di][qi][1] * inv * bf2f((u16)(zz.x >> 16)));
      ov.y = pack2(st.o[0][di][qi][2] * inv * bf2f((u16)(zz.y & 0xffff)), st.o[0][di][qi][3] * inv * bf2f((u16)(zz.y >> 16)));
      if (!g_dry) *(uint2*)(zb + d0) = ov;
    }
  }
}

template <int NQT>
__device__ void item_nsa(PP p, int id, u16* smem, float* imp, unsigned* selm, float* resp, bool g_dry) {
  constexpr int NQ = NQT * 16;
  constexpr int NBLK = 2048 / NQ;
  const int tid = ltid(), lane = tid & 63, wave = tid >> 6, lr = lane & 15, lq = lane >> 4;
  const int blk = NBLK - 1 - (id >> 3), b = id & 7;
  const int s0 = blk * NQ, qblk = s0 >> 6, h = wave;
  int spos[NQT];
#pragma unroll
  for (int qi = 0; qi < NQT; ++qi) spos[qi] = s0 + qi * 16 + lr;
  const float* gp = WSP(float, O_NG) + ((long)b * 2048) * 12 + h * 3;
  ASt<NQT, 1> st;
  st.reset();
#pragma unroll
  for (int qi = 0; qi < NQT; ++qi) {
    const u16* qp = WSP(u16, O_NQ) + ((long)((b * 4 + h) * 2048 + spos[qi])) * 64 + lq * 8;
    st.q[qi][0] = *(const bf16x8*)qp;
    st.q[qi][1] = *(const bf16x8*)(qp + 32);
  }
  int imaxc = (s0 + NQ - 1 - 31) >> 4;
  if (imaxc > 126) imaxc = 126;
  const int kt1c = imaxc < 0 ? 0 : (imaxc >> 6) + 1;
  auto cmask = [&](int key, int qi) { return key < 127 && 16 * key + 31 <= spos[qi]; };
  KVsrc csrc{WSP(u16, O_KCMP) + (long)b * 128 * 64, WSP(u16, O_VCMP) + (long)b * 128 * 64, 64};
  attn_pass<NQT, 1>(st, csrc, 0, kt1c, 0.125f, smem, cmask, [&](int kt) { return true; }, [&](int kt) { return true; });
  float invl[NQT];
#pragma unroll
  for (int qi = 0; qi < NQT; ++qi) {
    float lt = quadsum(st.l[0][qi]);
    invl[qi] = lt > 0.f ? 1.f / lt : 0.f;
    float sc = gp[spos[qi] * 12 + 0] * invl[qi];
#pragma unroll
    for (int di = 0; di < 4; ++di)
#pragma unroll
      for (int j = 0; j < 4; ++j) resp[((di * NQT + qi) * 4 + j) * 256 + tid] = st.o[0][di][qi][j] * sc;
  }
  unsigned selq[NQT];
#pragma unroll
  for (int qi = 0; qi < NQT; ++qi) selq[qi] = (qblk == 31) ? 0xffffffffu : ((1u << (qblk + 1)) - 1u);
  if (qblk >= 16) {
    for (int i = tid; i < NQ * 33; i += 256) imp[i] = 0.f;
    if (tid < NQ) selm[tid] = 0u;
    __syncthreads();
    for (int hh = 0; hh < 4; ++hh) {
      if (wave == hh) {
#pragma unroll
        for (int kt = 0; kt < 2; ++kt) {
          const char* sk = (const char*)smem + kt * KBUF;
#pragma unroll
          for (int ki = 0; ki < 4; ++ki) {
            const char* kp = sk + (ki * 16 + lr) * 128;
            const int kf = (lr >> 1) & 7;
            bf16x8 k0 = *(const bf16x8*)(kp + ((lq ^ kf) << 4)), k1 = *(const bf16x8*)(kp + (((4 + lq) ^ kf) << 4));
#pragma unroll
            for (int qi = 0; qi < NQT; ++qi) {
              f32x4 z = {0.f, 0.f, 0.f, 0.f};
              z = mfma16(k0, st.q[qi][0], z);
              z = mfma16(k1, st.q[qi][1], z);
              float pr[4];
#pragma unroll
              for (int j = 0; j < 4; ++j) {
                int key = kt * 64 + ki * 16 + lq * 4 + j;
                pr[j] = cmask(key, qi) ? __expf((z[j] - st.m[0][qi]) * 0.125f) * invl[qi] : 0.f;
              }
              float* ip = imp + (qi * 16 + lr) * 33 + kt * 16 + ki * 4 + lq;
              ip[0] += 2.f * (pr[0] + pr[1] + pr[2]) + pr[3];
              __builtin_amdgcn_wave_barrier();
              ip[1] += pr[3];
              __builtin_amdgcn_wave_barrier();
            }
          }
        }
      }
      __syncthreads();
    }
    {
      constexpr int TPQ = 256 / NQ;
      constexpr int JPT = 32 / TPQ;
      int q = tid / TPQ;
      unsigned bits = 0u;
      if ((tid % TPQ) == 0) bits = 1u | (1u << qblk) | (1u << (qblk - 1));
#pragma unroll
      for (int e = 0; e < JPT; ++e) {
        int j = (tid % TPQ) * JPT + e;
        if (j >= 1 && j <= qblk - 2) {
          float v = imp[q * 33 + j];
          int rank = 0;
          for (int j2 = 1; j2 <= qblk - 2; ++j2) {
            float v2 = imp[q * 33 + j2];
            rank += (v2 > v || (v2 == v && j2 < j)) ? 1 : 0;
          }
          if (rank < 13) bits |= 1u << j;
        }
      }
      if (bits) atomicOr(&selm[q], bits);
    }
    __syncthreads();
#pragma unroll
    for (int qi = 0; qi < NQT; ++qi) selq[qi] = selm[qi * 16 + lr];
  }
#pragma unroll
  for (int qi = 0; qi < NQT; ++qi) {
    const float2* tab = WSP(float2, O_ROPE32) + spos[qi] * 32 + lq * 8;
    bf16x8 a = st.q[qi][0], c2 = st.q[qi][1];
#pragma unroll
    for (int j = 0; j < 8; ++j) {
      float2 cs = tab[j];
      float x1 = bf2f((u16)a[j]), x2 = bf2f((u16)c2[j]);
      a[j] = (short)f2bf(x1 * cs.x - x2 * cs.y);
      c2[j] = (short)f2bf(x2 * cs.x + x1 * cs.y);
    }
    st.q[qi][0] = a; st.q[qi][1] = c2;
  }
  st.reset();
  {
    KVsrc ssrc{WSP(u16, O_KSR) + (long)b * 2048 * 64, WSP(u16, O_VS) + (long)b * 2048 * 64, 64};
    unsigned selany = 0u;
#pragma unroll
    for (int qi = 0; qi < NQT; ++qi) selany |= selq[qi];
    attn_pass<NQT, 1>(st, ssrc, 0, qblk + 1, 0.125f, smem,
                      [&](int key, int qi) { return ((selq[qi] >> (key >> 6)) & 1u) && key <= spos[qi]; },
                      [&](int kt) { return __ballot(((selany >> kt) & 1u) != 0u) != 0ull; },
                      [&](int kt) { return true; });
#pragma unroll
    for (int qi = 0; qi < NQT; ++qi) {
      float lt = quadsum(st.l[0][qi]);
      float sc = lt > 0.f ? gp[spos[qi] * 12 + 1] / lt : 0.f;
#pragma unroll
      for (int di = 0; di < 4; ++di)
#pragma unroll
        for (int j = 0; j < 4; ++j) resp[((di * NQT + qi) * 4 + j) * 256 + tid] += st.o[0][di][qi][j] * sc;
    }
  }
  st.reset();
  {
    KVsrc wsrc{WSP(u16, O_KWR) + (long)b * 2048 * 64, WSP(u16, O_VW) + (long)b * 2048 * 64, 64};
    int lo = s0 - 511; if (lo < 0) lo = 0;
    attn_pass<NQT, 1>(st, wsrc, lo >> 6, qblk + 1, 0.125f, smem,
                      [&](int key, int qi) { return key <= spos[qi] && key > spos[qi] - 512; },
                      [&](int kt) { return true; },
                      [&](int kt) { return !(kt * 64 + 63 <= s0 && kt * 64 > s0 + NQ - 1 - 512); });
#pragma unroll
    for (int qi = 0; qi < NQT; ++qi) {
      float lt = quadsum(st.l[0][qi]);
      float sc = lt > 0.f ? gp[spos[qi] * 12 + 2] / lt : 0.f;
#pragma unroll
      for (int di = 0; di < 4; ++di)
#pragma unroll
        for (int j = 0; j < 4; ++j) resp[((di * NQT + qi) * 4 + j) * 256 + tid] += st.o[0][di][qi][j] * sc;
    }
  }
#pragma unroll
  for (int qi = 0; qi < NQT; ++qi) {
    u16* zb = WSP(u16, O_SZ) + (long)3 * T * 256 + ((long)b * 2048 + spos[qi]) * 256 + h * 64;
#pragma unroll
    for (int di = 0; di < 4; ++di) {
      int d0 = di * 16 + lq * 4;
      uint2 zz = *(const uint2*)(zb + d0);
      uint2 ov;
      const float* rp = resp + ((di * NQT + qi) * 4) * 256 + tid;
      ov.x = pack2(rp[0] * bf2f((u16)(zz.x & 0xffff)), rp[256] * bf2f((u16)(zz.x >> 16)));
      ov.y = pack2(rp[512] * bf2f((u16)(zz.y & 0xffff)), rp[768] * bf2f((u16)(zz.y >> 16)));
      if (!g_dry) *(uint2*)(zb + d0) = ov;
    }
  }
}

__device__ void item_s5_local(PP p, int l, int id) {
  const int lane = ltid() & 63, wave = ltid() >> 6;
  const int u = id * 4 + wave;
  const int c = u & 31, g = (u >> 5) & 15, b = u >> 9;
  const float* sp = WSP(float, O_S5P + l * SZ_S5P);
  const int gn = g * 64 + lane;
  const float are = sp[gn], aim = sp[1024 + gn];
  float bre[16], bim[16];
#pragma unroll
  for (int q = 0; q < 4; ++q) {
    float4 t1 = *(const float4*)(sp + 4096 + gn * 16 + q * 4);
    float4 t2 = *(const float4*)(sp + 4096 + 16384 + gn * 16 + q * 4);
    bre[q * 4] = t1.x; bre[q * 4 + 1] = t1.y; bre[q * 4 + 2] = t1.z; bre[q * 4 + 3] = t1.w;
    bim[q * 4] = t2.x; bim[q * 4 + 1] = t2.y; bim[q * 4 + 2] = t2.z; bim[q * 4 + 3] = t2.w;
  }
  const float* su = WSP(float, O_SU) + ((long)b * 2048 + c * 64) * 256 + g * 16;
  float xr = 0.f, xi = 0.f;
  float uvs[16];
#pragma unroll
  for (int t4 = 0; t4 < 16; ++t4) uvs[t4] = su[(long)(t4 * 4 + (lane >> 4)) * 256 + (lane & 15)];
#pragma unroll
  for (int t4 = 0; t4 < 16; ++t4) {
    float uv = uvs[t4];
#pragma unroll
    for (int tt = 0; tt < 4; ++tt) {
      f32x2_t bu2 = {0.f, 0.f}, bu3 = {0.f, 0.f};
#pragma unroll
      for (int q = 0; q < 16; q += 4) {
        float u0 = __int_as_float(__builtin_amdgcn_readlane(__float_as_int(uv), tt * 16 + q));
        float u1 = __int_as_float(__builtin_amdgcn_readlane(__float_as_int(uv), tt * 16 + q + 1));
        float u2 = __int_as_float(__builtin_amdgcn_readlane(__float_as_int(uv), tt * 16 + q + 2));
        float u3 = __int_as_float(__builtin_amdgcn_readlane(__float_as_int(uv), tt * 16 + q + 3));
        bu2 = __builtin_elementwise_fma(f32x2_t{bre[q], bim[q]}, f32x2_t{u0, u0}, bu2);
        bu3 = __builtin_elementwise_fma(f32x2_t{bre[q + 1], bim[q + 1]}, f32x2_t{u1, u1}, bu3);
        bu2 = __builtin_elementwise_fma(f32x2_t{bre[q + 2], bim[q + 2]}, f32x2_t{u2, u2}, bu2);
        bu3 = __builtin_elementwise_fma(f32x2_t{bre[q + 3], bim[q + 3]}, f32x2_t{u3, u3}, bu3);
      }
      bu2 += bu3;
      float nr = are * xr - aim * xi + bu2.x;
      float ni = are * xi + aim * xr + bu2.y;
      xr = nr; xi = ni;
    }
  }
  WSP(float2, O_S5E)[(long)u * 64 + lane] = float2{xr, xi};
}

__device__ void item_s5_out(PP p, int l, int id, u16* smem) {
  const int lane = ltid() & 63, wave = ltid() >> 6, lr = lane & 15, lq = lane >> 4;
  const int u = id * 4 + wave;
  const int c = u & 31, g = (u >> 5) & 15, b = u >> 9;
  const float* sp = WSP(float, O_S5P + l * SZ_S5P);
  const int gn = g * 64 + lane;
  const float are = sp[gn], aim = sp[1024 + gn], aLr = sp[2048 + gn], aLi = sp[3072 + gn];
  float bre[16], bim[16];
#pragma unroll
  for (int q = 0; q < 4; ++q) {
    float4 t1 = *(const float4*)(sp + 4096 + gn * 16 + q * 4);
    float4 t2 = *(const float4*)(sp + 4096 + 16384 + gn * 16 + q * 4);
    bre[q * 4] = t1.x; bre[q * 4 + 1] = t1.y; bre[q * 4 + 2] = t1.z; bre[q * 4 + 3] = t1.w;
    bim[q * 4] = t2.x; bim[q * 4 + 1] = t2.y; bim[q * 4 + 2] = t2.z; bim[q * 4 + 3] = t2.w;
  }
  float xr = 0.f, xi = 0.f;
  const float2* e = WSP(float2, O_S5E) + (long)(u - c) * 64 + lane;
#pragma unroll 8
  for (int cc = 0; cc < c; ++cc) {
    float2 ev = e[(long)cc * 64];
    float nr = aLr * xr - aLi * xi + ev.x;
    float ni = aLr * xi + aLi * xr + ev.y;
    xr = nr; xi = ni;
  }
  bf16x8 cm[4];
#pragma unroll
  for (int ks = 0; ks < 4; ++ks) {
    const float* cp = (ks < 2 ? p->s5_cre : p->s5_cim) + (long)l * 16384 + (long)(g * 16 + lr) * 64 + (ks & 1) * 32 + lq * 8;
    float4 c0 = *(const float4*)cp, c1 = *(const float4*)(cp + 4);
    float sg = ks < 2 ? 1.f : -1.f;
    union { unsigned w[4]; bf16x8 v; } pk;
    pk.w[0] = pack2(sg * c0.x, sg * c0.y); pk.w[1] = pack2(sg * c0.z, sg * c0.w);
    pk.w[2] = pack2(sg * c1.x, sg * c1.y); pk.w[3] = pack2(sg * c1.z, sg * c1.w);
    cm[ks] = pk.v;
  }
  const float dsk = p->s5_d[l * 256 + g * 16 + lr];
  u16* X = smem + wave * 16 * 144;
  const long tok0 = (long)b * 2048 + c * 64;
  const float* su = WSP(float, O_SU) + tok0 * 256 + g * 16;
  u16* yg = WSP(u16, O_YG) + tok0 * 256 + g * 16;
  float uall[16];
#pragma unroll
  for (int t4 = 0; t4 < 16; ++t4) uall[t4] = su[(long)(t4 * 4 + (lane >> 4)) * 256 + (lane & 15)];
#pragma unroll
  for (int sub = 0; sub < 4; ++sub) {
    float ue[4];
#pragma unroll
    for (int j = 0; j < 4; ++j) ue[j] = su[(long)(sub * 16 + lq * 4 + j) * 256 + lr];
    __syncthreads();
#pragma unroll
    for (int t4 = 0; t4 < 4; ++t4) {
      float uv = uall[sub * 4 + t4];
#pragma unroll
      for (int tt = 0; tt < 4; ++tt) {
        f32x2_t bu2 = {0.f, 0.f}, bu3 = {0.f, 0.f};
#pragma unroll
        for (int q = 0; q < 16; q += 4) {
          float u0 = __int_as_float(__builtin_amdgcn_readlane(__float_as_int(uv), tt * 16 + q));
          float u1 = __int_as_float(__builtin_amdgcn_readlane(__float_as_int(uv), tt * 16 + q + 1));
          float u2 = __int_as_float(__builtin_amdgcn_readlane(__float_as_int(uv), tt * 16 + q + 2));
          float u3 = __int_as_float(__builtin_amdgcn_readlane(__float_as_int(uv), tt * 16 + q + 3));
          bu2 = __builtin_elementwise_fma(f32x2_t{bre[q], bim[q]}, f32x2_t{u0, u0}, bu2);
          bu3 = __builtin_elementwise_fma(f32x2_t{bre[q + 1], bim[q + 1]}, f32x2_t{u1, u1}, bu3);
          bu2 = __builtin_elementwise_fma(f32x2_t{bre[q + 2], bim[q + 2]}, f32x2_t{u2, u2}, bu2);
          bu3 = __builtin_elementwise_fma(f32x2_t{bre[q + 3], bim[q + 3]}, f32x2_t{u3, u3}, bu3);
        }
        bu2 += bu3;
        float nr = are * xr - aim * xi + bu2.x;
        float ni = are * xi + aim * xr + bu2.y;
        xr = nr; xi = ni;
        X[(t4 * 4 + tt) * 144 + lane] = f2bf(xr);
        X[(t4 * 4 + tt) * 144 + 64 + lane] = f2bf(xi);
      }
    }
    __syncthreads();
    f32x4 y = {0.f, 0.f, 0.f, 0.f};
#pragma unroll
    for (int ks = 0; ks < 4; ++ks) {
      bf16x8 xa = *(const bf16x8*)(X + lr * 144 + ks * 32 + lq * 8);
      y = mfma16(xa, cm[ks], y);
    }
#pragma unroll
    for (int j = 0; j < 4; ++j) {
      int tl = sub * 16 + lq * 4 + j;
      yg[(long)tl * 256 + lr] = f2bf(gelu(y[j] + dsk * ue[j]));
    }
  }
}

__device__ void item_memkv(PP p, int u, u16* smem) {
  const int wave = ltid() >> 6, wr = wave >> 1, wc = wave & 1;
  f32x4 acc[4][4];
#pragma unroll
  for (int i = 0; i < 4; ++i)
#pragma unroll
    for (int j = 0; j < 4; ++j) acc[i][j] = f32x4{0.f, 0.f, 0.f, 0.f};
  int ll = u >> 6; u &= 63; int rt = u >> 2, ct = u & 3;
  gemm_core(acc, WSP(u16, O_MEMH) + ((long)ll * 2048 + rt * 128) * 1024, 1024, WSP(u16, O_WKVT + ll * SZ_WKVT) + (long)ct * 128 * 1024, 1024, 1024, smem);
  int bb = rt >> 1, m0 = (rt & 1) * 128 + wr * 64, cc = ct * 2 + wc;
  u16* dst = WSP(u16, cc < 4 ? O_MEMK : O_MEMV) + (long)ll * 8 * 4 * 256 * 64 + ((long)((bb * 4 + (cc & 3)) * 256 + m0)) * 64;
  store_tile_bf16<0>(acc, dst, 64, smem);
}

__device__ void phase2(PP p, int l, u16* smem, int* shi, int rep) {
  const bool g_dry = rep > 0;
  unsigned* ctr = WSP(unsigned, O_CTR) + l * 8 + 0 + rep * 16;
  const int wave = ltid() >> 6, wr = wave >> 1, wc = wave & 1, lane = ltid() & 63, lr = lane & 15;
  int it = blockIdx.x;
  for (;;) {
    p = getP();
    const int nkv = l == 0 ? 128 : 0;
    if (it >= 32 + nkv + 1024 + 1024) break;
    do {
    if (it >= 32 && it < 32 + nkv) { if (rep == 0) item_memkv(p, it - 32, smem); continue; }
    if (it >= 32) it -= nkv;
    if (it < 32) {
      if (!PON(rep, 1)) continue;
      int kv = it >> 4, bb = (it >> 1) & 7, ct = it & 1;
      f32x4 acc[4][4];
#pragma unroll
      for (int i = 0; i < 4; ++i)
#pragma unroll
        for (int j = 0; j < 4; ++j) acc[i][j] = f32x4{0.f, 0.f, 0.f, 0.f};
      gemm_core(acc, WSP(u16, kv ? O_VC : O_KC) + (long)bb * 2048 * 64, 1024, WSP(u16, O_W1T + l * SZ_W1T) + ((long)kv * 256 + ct * 128) * 2048, 2048, 2048, smem);
      const float* bpe = WSP(float, O_BPE) + (l * 2 + kv) * 16 * 256 + ct * 128 + wc * 64;
#pragma unroll
      for (int ni = 0; ni < 4; ++ni) {
        float bv = 0.f;
#pragma unroll
        for (int kc = 0; kc < 16; ++kc) bv += bpe[kc * 256 + ni * 16 + lr];
#pragma unroll
        for (int mi = 0; mi < 4; ++mi)
#pragma unroll
          for (int j = 0; j < 4; ++j) acc[mi][ni][j] += bv;
      }
      store_tile_bf16<2>(acc, WSP(u16, O_CHID) + ((long)kv * 1024 + bb * 128 + wr * 64) * 256 + ct * 128 + wc * 64, 256, smem);
    } else if (((it - 32) & 1) == 0) {
      if (PON(rep, 2)) item_diff(p, l, (it - 32) >> 1, smem, g_dry);
    } else {
      if (PON(rep, 4)) item_s5_local(p, l, (it - 32) >> 1);
    }
    } while (0);
    it = (int)gridDim.x + fetch_item(ctr, shi);
  }
}

__device__ void phase3(PP p, int l, u16* smem, int* shi, int rep) {
  const bool g_dry = rep > 0;
  const int wave = ltid() >> 6, wr = wave >> 1, wc = wave & 1;
  const int G = gridDim.x;
  for (int it = blockIdx.x; it < 16; it += G) {
    p = getP();
    int kv = it >> 3, bb = it & 7;
    f32x4 acc[4][4];
#pragma unroll
    for (int i = 0; i < 4; ++i)
#pragma unroll
      for (int j = 0; j < 4; ++j) acc[i][j] = f32x4{0.f, 0.f, 0.f, 0.f};
    gemm_core(acc, WSP(u16, O_CHID) + ((long)kv * 1024 + bb * 128) * 256, 256, WSP(u16, O_W2T + l * SZ_W2T) + (long)kv * 128 * 256, 256, 256, smem);
    if (wc == 0) store_tile_bf16<0>(acc, WSP(u16, kv ? O_VCMP : O_KCMP) + ((long)bb * 128 + wr * 64) * 64, 64, smem);
    __syncthreads();
  }
  const int rot = ((blockIdx.x >> 8) & 1) ? 3 : 0;
  for (int r0 = 0; r0 < 6; ++r0) {
    int r = r0 + rot; if (r >= 6) r -= 6;
    for (int it = blockIdx.x; it < (r == 2 ? 512 : (r == 0 || r == 4 ? 1024 / 2 : 512)); it += G) {
      p = getP();
      __syncthreads();
      if (r == 0) { if (PON(rep, 8)) item_s5_out(p, l, it, smem); }
      if (r == 4) { if (PON(rep, 8)) item_s5_out(p, l, 512 + it, smem); }
      const int itx = (((it & 7) * 4 + ((it >> 7) & 3)) << 4) | ((it >> 3) & 15);
      if (r == 2) { if (PON(rep, 4)) item_mem(p, l, itx, smem, g_dry); }
      else if (r != 0 && r != 4) { if (PON(rep, 2)) item_dilated(p, ((r - 1) >> 1) * 512 + itx, smem); }
    }
  }
  __syncthreads();
}

__device__ void phase4(PP p, int l, u16* smem, int* shi, float* imp, unsigned* selm, float* resp, int rep) {
  const bool g_dry = rep > 0;
  auto dil_combine = [&](int chunk) {
  for (long i = (long)chunk * 1024 + ltid(); i < (long)(chunk + 1) * 1024; i += 256) {
    long t = i >> 5; int h = (int)(i >> 3) & 3, dc = (int)i & 7;
    float l0 = WSP(float, O_DLSE)[t * 4 + h], l1 = WSP(float, O_DLSE)[(long)T * 4 + t * 4 + h], l2 = WSP(float, O_DLSE)[(long)2 * T * 4 + t * 4 + h];
    float mx = fmaxf(l0, fmaxf(l1, l2));
    float w0 = __expf(l0 - mx), w1 = __expf(l1 - mx), w2 = __expf(l2 - mx);
    float inv = 1.f / (w0 + w1 + w2);
    w0 *= inv; w1 *= inv; w2 *= inv;
    long off = t * 256 + h * 64 + dc * 8;
    uint4 a0 = *(const uint4*)(WSP(u16, O_DILO) + off), a1 = *(const uint4*)(WSP(u16, O_DILO) + (long)T * 256 + off), a2 = *(const uint4*)(WSP(u16, O_DILO) + (long)2 * T * 256 + off);
    u16* zb = WSP(u16, O_SZ) + (long)1 * T * 256 + off;
    uint4 zz = *(const uint4*)zb;
    uint4 ov;
    auto mixw = [&](unsigned x0, unsigned x1, unsigned x2, unsigned z) {
      float lo = (w0 * bf2f((u16)(x0 & 0xffff)) + w1 * bf2f((u16)(x1 & 0xffff)) + w2 * bf2f((u16)(x2 & 0xffff))) * bf2f((u16)(z & 0xffff));
      float hi = (w0 * bf2f((u16)(x0 >> 16)) + w1 * bf2f((u16)(x1 >> 16)) + w2 * bf2f((u16)(x2 >> 16))) * bf2f((u16)(z >> 16));
      return pack2(lo, hi);
    };
    ov.x = mixw(a0.x, a1.x, a2.x, zz.x); ov.y = mixw(a0.y, a1.y, a2.y, zz.y);
    ov.z = mixw(a0.z, a1.z, a2.z, zz.z); ov.w = mixw(a0.w, a1.w, a2.w, zz.w);
    if (!g_dry) *(uint4*)zb = ov;
  }
  };
  unsigned* ctr = WSP(unsigned, O_CTR) + l * 8 + 2 + rep * 16;
  const int lane = ltid() & 63, wave = ltid() >> 6, wr = wave >> 1, wc = wave & 1, lr = lane & 15, lq = lane >> 4;
  int it = blockIdx.x;
  for (;;) {
    p = getP();
    constexpr int NNSA = 8 * 2048 / (NSA_NQT * 16);
    if (it >= NNSA + 512 + 512) break;
    if (it >= NNSA + 512) { if (PON(rep, 1)) dil_combine(it - NNSA - 512); it = (int)gridDim.x + fetch_item(ctr, shi); continue; }
    do {
    if (it < NNSA) {
      if (PON(rep, 2)) item_nsa<NSA_NQT>(p, it, smem, imp, selm, resp, g_dry);
    } else {
      if (!PON(rep, 4)) continue;
      int u = it - NNSA; int rt = u >> 2, ct = u & 3;
      f32x4 acc[4][4];
#pragma unroll
      for (int i = 0; i < 4; ++i)
#pragma unroll
        for (int j = 0; j < 4; ++j) acc[i][j] = f32x4{0.f, 0.f, 0.f, 0.f};
      gemm_core(acc, WSP(u16, O_YG) + (long)rt * 128 * 256, 256, WSP(u16, O_WGT + l * SZ_WGT) + (long)ct * 128 * 256, 256, 256, smem);
      const int cbase = (ct * 128 + wc * 64) >> 1;
      u16* zb = WSP(u16, O_SZ) + (long)2 * T * 256 + ((long)rt * 128 + wr * 64) * 256 + cbase;
      u16* patch = smem + wave * (64 * 40);
#pragma unroll
      for (int nn = 0; nn < 2; ++nn) {
        int ch = cbase + nn * 16 + lr;
        float bv = p->b_glu[l * 512 + ch], bg = p->b_glu[l * 512 + 256 + ch];
#pragma unroll
        for (int mi = 0; mi < 4; ++mi)
#pragma unroll
          for (int j = 0; j < 4; ++j)
            patch[(mi * 16 + lq * 4 + j) * 40 + nn * 16 + lr] = f2bf((acc[mi][2 * nn][j] + bv) * sigm(acc[mi][2 * nn + 1][j] + bg));
      }
      __builtin_amdgcn_wave_barrier();
#pragma unroll
      for (int i = 0; i < 4; ++i) {
        const int row = i * 16 + (lane >> 2), c8 = (lane & 3) * 8;
        u32x4 pv = *(const u32x4*)(patch + row * 40 + c8);
        u32x4 zz = *(const u32x4*)(zb + (long)row * 256 + c8);
        u32x4 ov;
#pragma unroll
        for (int k = 0; k < 4; ++k)
          ov[k] = pack2(bf2f((u16)(pv[k] & 0xffff)) * bf2f((u16)(zz[k] & 0xffff)), bf2f((u16)(pv[k] >> 16)) * bf2f((u16)(zz[k] >> 16)));
        if (!g_dry) *(u32x4*)(zb + (long)row * 256 + c8) = ov;
      }
      __builtin_amdgcn_wave_barrier();
    }
    } while (0);
    it = (int)gridDim.x + fetch_item(ctr, shi);
  }
}

__device__ void phase5(PP p, int l, u16* smem, unsigned* priv) {
  for (int t = blockIdx.x; t < 1024; t += gridDim.x) {
    p = getP();
    int rt, ct;
    if (gridDim.x == 512) { const int xcd = t & 7, slot = (t >> 3) & 63, rnd = t >> 9; rt = ((rnd * 8 + xcd) << 3) + (slot >> 3); ct = slot & 7; }
    else { rt = t >> 3; ct = t & 7; }
    f32x4 mix[4][4];
#pragma unroll
    for (int i = 0; i < 4; ++i)
#pragma unroll
      for (int j = 0; j < 4; ++j) mix[i][j] = f32x4{0.f, 0.f, 0.f, 0.f};
    for (int n = 0; n < 5; ++n) {
      f32x4 acc[4][4];
#pragma unroll
      for (int i = 0; i < 4; ++i)
#pragma unroll
        for (int j = 0; j < 4; ++j) acc[i][j] = f32x4{0.f, 0.f, 0.f, 0.f};
      float bvs[4];
      {
        const int t0 = ltid(), wc0 = (t0 >> 6) & 1, lr0 = t0 & 15;
#pragma unroll
        for (int ni = 0; ni < 4; ++ni) bvs[ni] = p->b_merge[l * 5120 + n * 1024 + ct * 128 + wc0 * 64 + ni * 16 + lr0];
      }
      gemm_core<true>(acc, (const u16*)(p->ws + O_H8 + (long)rt * 128 * 1024), 512, (const u16*)(p->ws + O_WM8 + l * SZ_WM8 + ((long)n * 1024 + ct * 128) * 1024), 512, 1024, smem);
      unsigned gp[4][4];
      const int t1 = ltid(), wc1 = (t1 >> 6) & 1, lr1 = t1 & 15;
#pragma unroll
      for (int ni = 0; ni < 4; ++ni) {
        float bv = bvs[ni];
#pragma unroll
        for (int mi = 0; mi < 4; ++mi) {
          unsigned q0 = (unsigned)(sigm(acc[mi][ni][0] * 0.03125f + bv) * 255.f + 0.5f), q1 = (unsigned)(sigm(acc[mi][ni][1] * 0.03125f + bv) * 255.f + 0.5f);
          unsigned q2 = (unsigned)(sigm(acc[mi][ni][2] * 0.03125f + bv) * 255.f + 0.5f), q3 = (unsigned)(sigm(acc[mi][ni][3] * 0.03125f + bv) * 255.f + 0.5f);
          gp[mi][ni] = q0 | (q1 << 8) | (q2 << 16) | (q3 << 24);
          acc[mi][ni] = f32x4{0.f, 0.f, 0.f, 0.f};
        }
      }
      gemm_core(acc, WSP(u16, O_SZ) + (long)n * T * 256 + (long)rt * 128 * 256, 256, WSP(u16, O_WBT + l * SZ_WBT) + ((long)n * 1024 + ct * 128) * 256, 256, 256, smem);
#pragma unroll
      for (int mi = 0; mi < 4; ++mi)
#pragma unroll
        for (int ni = 0; ni < 4; ++ni) {
          unsigned g0 = gp[mi][ni];
          mix[mi][ni][0] += (float)(g0 & 0xffu) * (1.f / 255.f) * acc[mi][ni][0];
          mix[mi][ni][1] += (float)((g0 >> 8) & 0xffu) * (1.f / 255.f) * acc[mi][ni][1];
          mix[mi][ni][2] += (float)((g0 >> 16) & 0xffu) * (1.f / 255.f) * acc[mi][ni][2];
          mix[mi][ni][3] += (float)(g0 >> 24) * (1.f / 255.f) * acc[mi][ni][3];
        }
    }
    const int t2 = ltid(), wr2 = t2 >> 7, wc2 = (t2 >> 6) & 1;
    store_tile_bf16<0>(mix, WSP(u16, O_MIXED) + ((long)rt * 128 + wr2 * 64) * 1024 + ct * 128 + wc2 * 64, 1024, smem);
  }
}

__device__ void phase6(PP p, int l, u16* smem) {
  const int lane = ltid() & 63, wave = ltid() >> 6, wr = wave >> 1, wc = wave & 1, lr = lane & 15, lq = lane >> 4;
  const float* xin = l == 0 ? p->x : p->out;
  for (int t = blockIdx.x; t < 1024; t += gridDim.x) {
    p = getP();
    int rt, ct;
    if (gridDim.x == 512) { const int xcd = t & 7, slot = (t >> 3) & 63, rnd = t >> 9; rt = ((rnd * 8 + xcd) << 3) + (slot >> 3); ct = slot & 7; }
    else { rt = t >> 3; ct = t & 7; }
    f32x4 acc[4][4];
#pragma unroll
    for (int i = 0; i < 4; ++i)
#pragma unroll
      for (int j = 0; j < 4; ++j) acc[i][j] = f32x4{0.f, 0.f, 0.f, 0.f};
    gemm_core(acc, WSP(u16, O_MIXED) + (long)rt * 128 * 1024, 1024, WSP(u16, O_WOT + l * SZ_WOT) + (long)ct * 128 * 1024, 1024, 1024, smem);
    const int t6 = ltid(), wr6 = t6 >> 7, wc6 = (t6 >> 6) & 1;
    const long base = ((long)rt * 128 + wr6 * 64) * 1024 + ct * 128 + wc6 * 64;
    store_tile_f32(acc, p->out + base, xin + base, 1024, smem);
  }
}

__device__ void phase7(PP p, int l) {
  const int wave = ltid() >> 6;
  for (int r0 = blockIdx.x * 4 + wave; r0 < T; r0 += gridDim.x * 16) {
#pragma unroll
    for (int u = 0; u < 4; ++u) {
      const int r = r0 + u * (int)gridDim.x * 4;
      if (r < T) {
        if (l == 0) rmsnorm_row<true>(p->out + (long)r * 1024, p->norm_g + 1024, WSP(u16, O_H) + (long)r * 1024, (unsigned char*)(p->ws + O_H8) + (long)r * 1024);
        else rmsnorm_row<false>(p->out + (long)r * 1024, p->final_g, p->out + (long)r * 1024);
      }
    }
  }
}

#ifndef REP_P0
#define REP_P0 1
#endif
#ifndef REP_P1
#define REP_P1 1
#endif

#define XB_TMO      128
#define XB_XCNT(j)  (256  + 64 * (j))
#define XB_XSUB(j)  (1280 + 64 * (j))
#define XB_XGEN(j)  (2304 + 64 * (j))
#define XB_TOP      3328
#define XB_TOPGEN   3392
#define XCD_BAR_WORDS 3456
#define XB_SPIN_CAP (1u << 18)
#define LAS __attribute__((address_space(3)))
__device__ __forceinline__ unsigned xb_ld(unsigned* q) { return __hip_atomic_load(q, __ATOMIC_RELAXED, __HIP_MEMORY_SCOPE_AGENT); }
__device__ __forceinline__ unsigned xb_add(unsigned* q, unsigned v) { return __hip_atomic_fetch_add(q, v, __ATOMIC_RELAXED, __HIP_MEMORY_SCOPE_AGENT); }
__device__ __forceinline__ unsigned xb_xcc_id() { return (unsigned)__builtin_amdgcn_s_getreg((3 << 11) | 20) & 0xFu; }
#define XB_SPIN(cond, bar) do { unsigned _sp = 0; while (cond) { __builtin_amdgcn_s_sleep(1); \
    if ((++_sp & 255u) == 0u) { if (xb_ld(&(bar)[XB_TMO])) break; if (_sp > XB_SPIN_CAP) { atomicAdd(&(bar)[XB_TMO], 1u); break; } } } } while (0)
struct XcdBarrier { unsigned* bar; unsigned x; volatile LAS unsigned* st; };
__device__ __forceinline__ XcdBarrier xcd_barrier_post(unsigned* bar, volatile LAS unsigned* st) {
  XcdBarrier b; b.bar = bar; b.x = xb_xcc_id(); b.st = st;
  if (threadIdx.x == 0) (void)xb_add(&bar[XB_XCNT(b.x)], 1u);
  return b;
}
__device__ __forceinline__ void xcd_barrier_complete(unsigned* bar, unsigned x, unsigned& nloc, unsigned& nx) {
  const unsigned G = gridDim.x * gridDim.y * gridDim.z;
  unsigned sum, cnt, mine, sp = 0u;
  for (;;) {
    sum = 0u; cnt = 0u; mine = 0u;
#pragma unroll
    for (unsigned j = 0; j < 16; ++j) { const unsigned c = xb_ld(&bar[XB_XCNT(j)]); sum += c; cnt += (c > 0u) ? 1u : 0u; mine = (j == x) ? c : mine; }
    if (sum == G) break;
    __builtin_amdgcn_s_sleep(1);
    if ((++sp & 255u) == 0u) { if (xb_ld(&bar[XB_TMO])) break; if (sp > XB_SPIN_CAP) { atomicAdd(&bar[XB_TMO], 1u); break; } }
  }
  nloc = mine > 0u ? mine : 1u; nx = cnt > 0u ? cnt : 1u;
}
__device__ __forceinline__ void xcd_barrier(volatile LAS unsigned* stw) {
  XcdBarrier b;
  b.bar = (unsigned*)(getP()->ws + O_BAR);
  b.x = xb_xcc_id();
  asm volatile("" : "+s"(b.x));
  b.st = stw;
  asm volatile("s_waitcnt vmcnt(0)" ::: "memory");
  __syncthreads();
  if (threadIdx.x == 0) {
    unsigned* bar = b.bar;
    __builtin_amdgcn_s_waitcnt(0);
    unsigned nloc = b.st[0], nx = b.st[1];
    if (nloc == 0u) { xcd_barrier_complete(bar, b.x, nloc, nx); b.st[0] = nloc; b.st[1] = nx; }
    const unsigned old = xb_add(&bar[XB_XSUB(b.x)], 1u);
    const unsigned gen = old / nloc;
    if (old + 1u == (gen + 1u) * nloc) {
      __builtin_amdgcn_fence(__ATOMIC_RELEASE, "agent");
      asm volatile("s_waitcnt vmcnt(0)" ::: "memory");
      const unsigned og = xb_add(&bar[XB_TOP], 1u);
      const unsigned tg = og / nx;
      if (og + 1u == (tg + 1u) * nx) xb_add(&bar[XB_TOPGEN], 1u);
      else XB_SPIN(xb_ld(&bar[XB_TOPGEN]) == tg, bar);
      __builtin_amdgcn_fence(__ATOMIC_ACQUIRE, "agent");
      xb_add(&bar[XB_XGEN(b.x)], 1u);
      asm volatile("s_waitcnt vmcnt(0)" ::: "memory");
    } else {
      XB_SPIN(xb_ld(&bar[XB_XGEN(b.x)]) == gen, bar);
      __builtin_amdgcn_fence(__ATOMIC_ACQUIRE, "agent");
      asm volatile("s_waitcnt vmcnt(0)" ::: "memory");
    }
  }
  __syncthreads();
}

#ifndef REP_P2
#define REP_P2 1
#endif
#ifndef REP_P3
#define REP_P3 1
#endif
#ifndef REP_P4
#define REP_P4 1
#endif
#ifndef REP_P5
#define REP_P5 1
#endif
#ifndef REP_P6
#define REP_P6 1
#endif
__device__ __forceinline__ int nrep(int n) { asm volatile("" : "+s"(n)); return n; }
__global__ void __launch_bounds__(256, 2) mixer_megakernel(P p_unused) {
  cg::grid_group grid = cg::this_grid();
  __shared__ __attribute__((aligned(16))) char smem_raw[73728 + 4224 + 128 + 32];
  unsigned* priv = (unsigned*)(smem_raw + 40960);
  float* imp = (float*)(smem_raw + 73728);
  unsigned* selm = (unsigned*)(smem_raw + 73728 + 4224);
  int& shi = *(int*)(smem_raw + 73728 + 4224 + 128);
  u16* smem = (u16*)smem_raw;
  {
    unsigned* stw = (unsigned*)(smem_raw + 73728 + 4224 + 128 + 16);
    if (threadIdx.x == 0) { stw[0] = 0u; stw[1] = 0u; }
    __syncthreads();
  }
  PP p0 = getP();
  volatile LAS unsigned* xbst = (volatile LAS unsigned*)(smem_raw + 73728 + 4224 + 128 + 16);
  (void)xcd_barrier_post((unsigned*)(p0->ws + O_BAR), xbst);
  if (p0->ws == nullptr) grid.sync();
  for (int rep = 0, n = nrep(REP_P0); rep < n; ++rep) phase_setup(getP(), smem_raw);
  xcd_barrier(xbst);
  for (int l = 0; l < 2; ++l) {
    for (int rep = 0, n = nrep(REP_P1); rep < n; ++rep) phase_gemm1(getP(), l, smem);
    xcd_barrier(xbst);
    for (int rep = nrep(REP_P2) - 1; rep >= 0; --rep) phase2(getP(), l, smem, &shi, rep);
    xcd_barrier(xbst);
    for (int rep = nrep(REP_P3) - 1; rep >= 0; --rep) phase3(getP(), l, smem, &shi, rep);
    xcd_barrier(xbst);
    for (int rep = nrep(REP_P4) - 1; rep >= 0; --rep) phase4(getP(), l, smem, &shi, imp, selm, (float*)priv, rep);
    xcd_barrier(xbst);
    for (int rep = 0, n = nrep(REP_P5); rep < n; ++rep) phase5(getP(), l, smem, priv);
    xcd_barrier(xbst);
    for (int rep = 0, n = nrep(l == 0 ? REP_P6 : 1); rep < n; ++rep) phase6(getP(), l, smem);
    xcd_barrier(xbst);
    phase7(getP(), l);
    if (l == 0) xcd_barrier(xbst);
  }
}

extern "C" void kernel_launch(void* const* d_in, const int* in_sizes, int n_in, void* d_out, int out_size, void* d_ws,
                              size_t ws_size, hipStream_t stream) {
  static int grid_blocks = 0;
  if (!grid_blocks) {
    int dev = 0, cus = 0, per = 0;
    hipGetDevice(&dev);
    hipDeviceGetAttribute(&cus, hipDeviceAttributeMultiprocessorCount, dev);
    hipOccupancyMaxActiveBlocksPerMultiprocessor(&per, mixer_megakernel, 256, 0);
    if (per > 2) per = 2;
    if (per < 1) per = 1;
    grid_blocks = cus * per;
  }
  if (ws_size < WS_NEED) fprintf(stderr, "workspace too small: %zu < %zu\n", ws_size, (size_t)WS_NEED);
  P hp{};
  const float** pp = (const float**)&hp;
  for (int i = 0; i < 26; ++i) pp[i] = (const float*)d_in[i];
  hp.out = (float*)d_out;
  hp.ws = (char*)d_ws;
  hipMemsetAsync((char*)d_ws + O_BAR, 0, 16384, stream);
  void* args[] = {&hp};
  hipError_t e = hipLaunchCooperativeKernel((void*)mixer_megakernel, dim3(grid_blocks), dim3(256), args, 0, stream);
  if (e != hipSuccess) fprintf(stderr, "cooperative launch failed: %s (grid %d)\n", hipGetErrorString(e), grid_blocks);
}
```

```cpp
#include <hip/hip_runtime.h>
#include <hip/hip_bf16.h>
#include <hip/hip_cooperative_groups.h>
#include <cstdio>
namespace cg = cooperative_groups;

typedef unsigned short u16;
typedef __attribute__((ext_vector_type(8))) short bf16x8;
typedef __attribute__((ext_vector_type(4))) short bf16x4;
typedef __attribute__((ext_vector_type(4))) float f32x4;
typedef __attribute__((ext_vector_type(4))) unsigned u32x4;

constexpr int T = 16384, S = 2048;
constexpr int NSA_NQT = 2;
#ifndef PMASK
#define PMASK 255
#endif
#define PON(rep, bit) ((rep) == 0 || ((PMASK) & (bit)))

struct P {
  const float *x, *mem, *norm_g, *w_in, *diff_lambda, *diff_subln_g, *s5_lre, *s5_lim, *s5_logdt, *s5_bre, *s5_bim,
      *s5_cre, *s5_cim, *s5_d, *w_glu, *b_glu, *nsa_pe, *nsa_w1, *nsa_w2, *mem_norm_g, *w_mem_kv, *w_merge, *b_merge,
      *w_branch, *w_out, *final_g;
  float* out;
  char* ws;
};

constexpr size_t SZ_WCAT = (size_t)4096 * 1024 * 2;
constexpr size_t SZ_WM8 = (size_t)5120 * 1024;
constexpr size_t SZ_WBT = (size_t)5 * 1024 * 256 * 2;
constexpr size_t SZ_WOT = (size_t)1024 * 1024 * 2;
constexpr size_t SZ_WGT = (size_t)512 * 256 * 2;
constexpr size_t SZ_WKVT = (size_t)512 * 1024 * 2;
constexpr size_t SZ_W1T = (size_t)2 * 256 * 2048 * 2;
constexpr size_t SZ_W2T = (size_t)2 * 128 * 256 * 2;
constexpr size_t SZ_HEADBUF = (size_t)8 * 4 * 2048 * 64 * 2;
constexpr size_t SZ_ONEBUF = (size_t)8 * 2048 * 64 * 2 + 8192;
constexpr size_t O_WCAT = 0;
constexpr size_t O_WBT = O_WCAT + 2 * SZ_WCAT;
constexpr size_t O_WOT = O_WBT + 2 * SZ_WBT;
constexpr size_t O_WGT = O_WOT + 2 * SZ_WOT;
constexpr size_t O_WKVT = O_WGT + 2 * SZ_WGT;
constexpr size_t O_W1T = O_WKVT + 2 * SZ_WKVT;
constexpr size_t O_W2T = O_W1T + 2 * SZ_W1T;
constexpr size_t O_H = O_W2T + 2 * SZ_W2T;
constexpr size_t O_SZ = O_H + (size_t)T * 1024 * 2;
constexpr size_t O_DQ = O_SZ + (size_t)5 * T * 256 * 2;
constexpr size_t O_DK = O_DQ + SZ_HEADBUF;
constexpr size_t O_DV = O_DK + SZ_HEADBUF;
constexpr size_t O_LQ = O_DV + SZ_HEADBUF;
constexpr size_t O_LK = O_LQ + SZ_HEADBUF;
constexpr size_t O_LV = O_LK + SZ_HEADBUF;
constexpr size_t O_NQ = O_LV + SZ_HEADBUF;
constexpr size_t O_MQ = O_NQ + SZ_HEADBUF;
constexpr size_t O_KC = O_MQ + SZ_HEADBUF;
constexpr size_t O_VC = O_KC + SZ_ONEBUF;
constexpr size_t O_KSR = O_VC + SZ_ONEBUF;
constexpr size_t O_VS = O_KSR + SZ_ONEBUF;
constexpr size_t O_KWR = O_VS + SZ_ONEBUF;
constexpr size_t O_VW = O_KWR + SZ_ONEBUF;
constexpr size_t O_SU = O_VW + SZ_ONEBUF;
constexpr size_t O_MEMH = O_SU + (size_t)T * 256 * 4;
constexpr size_t O_MEMK = O_MEMH + (size_t)2 * 2048 * 1024 * 2;
constexpr size_t O_MEMV = O_MEMK + (size_t)2 * 8 * 4 * 256 * 64 * 2;
constexpr size_t O_CHID = O_MEMV + (size_t)2 * 8 * 4 * 256 * 64 * 2;
constexpr size_t O_KCMP = O_CHID + (size_t)2 * 1024 * 256 * 2;
constexpr size_t O_VCMP = O_KCMP + (size_t)8 * 128 * 64 * 2;
constexpr size_t O_NG = O_VCMP + (size_t)8 * 128 * 64 * 2;
constexpr size_t O_DLSE = O_NG + (size_t)T * 12 * 4;
constexpr size_t O_S5E = O_DLSE + (size_t)3 * T * 4 * 4;
constexpr size_t O_S5P = O_S5E + (size_t)8 * 16 * 32 * 64 * 8;
constexpr size_t SZ_S5P = (size_t)(4096 + 32768) * 4;
constexpr size_t O_BPE = O_S5P + 2 * SZ_S5P;
constexpr size_t O_ROPE32 = O_BPE + (size_t)2 * 2 * 16 * 256 * 4;
constexpr size_t O_ROPE16 = O_ROPE32 + (size_t)2048 * 32 * 8;
constexpr size_t O_LAM = O_ROPE16 + (size_t)2048 * 16 * 8;
constexpr size_t O_CTR = O_LAM + 256;
constexpr size_t O_BAR = O_CTR + 256;
constexpr size_t O_WM8 = O_BAR + 16384;
constexpr size_t O_H8 = O_WM8 + 2 * SZ_WM8;
constexpr size_t WS_NEED = O_H8 + (size_t)T * 1024;
constexpr size_t O_DILO = O_DQ;
constexpr size_t O_MIXED = O_LQ;
constexpr size_t O_YG = O_MEMH;

typedef const __attribute__((address_space(4))) P* PP;
#define WSP(type, off) ((type*)(p->ws + (off)))
__device__ __forceinline__ int ltid() {
  int t = threadIdx.x;
  asm volatile("" : "+v"(t));
  return t;
}
__device__ __forceinline__ float shfx(float v, int mask, int lane) {
  return __int_as_float(__builtin_amdgcn_ds_bpermute((lane ^ mask) << 2, __float_as_int(v)));
}
typedef unsigned u32x2_t __attribute__((ext_vector_type(2)));
__device__ __forceinline__ float xmax16(float v) { u32x2_t r = __builtin_amdgcn_permlane16_swap(__float_as_uint(v), __float_as_uint(v), false, false); return fmaxf(__uint_as_float(r[0]), __uint_as_float(r[1])); }
__device__ __forceinline__ float xmax32(float v) { u32x2_t r = __builtin_amdgcn_permlane32_swap(__float_as_uint(v), __float_as_uint(v), false, false); return fmaxf(__uint_as_float(r[0]), __uint_as_float(r[1])); }
__device__ __forceinline__ float xsum16(float v) { u32x2_t r = __builtin_amdgcn_permlane16_swap(__float_as_uint(v), __float_as_uint(v), false, false); return __uint_as_float(r[0]) + __uint_as_float(r[1]); }
__device__ __forceinline__ float xsum32(float v) { u32x2_t r = __builtin_amdgcn_permlane32_swap(__float_as_uint(v), __float_as_uint(v), false, false); return __uint_as_float(r[0]) + __uint_as_float(r[1]); }
__device__ __forceinline__ PP getP() {
  PP k = (PP)__builtin_amdgcn_kernarg_segment_ptr();
  asm volatile("" : "+s"(k));
  return k;
}

typedef __bf16 bf16x2_t __attribute__((ext_vector_type(2)));
typedef float f32x2_t __attribute__((ext_vector_type(2)));
__device__ __forceinline__ u16 f2bf(float f) { return __builtin_bit_cast(u16, (__bf16)f); }
__device__ __forceinline__ float bf2f(u16 b) { return __uint_as_float(((unsigned)b) << 16); }
__device__ __forceinline__ unsigned pack2(float a, float b) { f32x2_t v = {a, b}; return __builtin_bit_cast(unsigned, __builtin_convertvector(v, bf16x2_t)); }
__device__ __forceinline__ float fexp(float x) { return __builtin_amdgcn_exp2f(x * 1.4426950408889634f); }
__device__ __forceinline__ float sigm(float x) { return __builtin_amdgcn_rcpf(1.f + fexp(-x)); }
__device__ __forceinline__ float silu(float x) { return x * __builtin_amdgcn_rcpf(1.f + fexp(-x)); }
__device__ __forceinline__ float gelu(float x) {
  float u = 0.7978845608028654f * (x + 0.044715f * x * x * x);
  float e = fexp(2.f * u);
  float th = 1.f - 2.f * __builtin_amdgcn_rcpf(e + 1.f);
  return 0.5f * x * (1.f + th);
}
typedef long i64x2 __attribute__((ext_vector_type(2)));
__device__ __forceinline__ unsigned pack4_fp8(float a, float b, float c, float d) {
  int r = __builtin_amdgcn_cvt_pk_fp8_f32(a, b, 0, false);
  r = __builtin_amdgcn_cvt_pk_fp8_f32(c, d, r, true);
  return (unsigned)r;
}
__device__ __forceinline__ f32x4 mfma16(bf16x8 a, bf16x8 b, f32x4 c) {
  return __builtin_amdgcn_mfma_f32_16x16x32_bf16(a, b, c, 0, 0, 0);
}
__device__ __forceinline__ int fetch_item(unsigned* ctr, int* sh) {
  __syncthreads();
  if (ltid() == 0) *sh = (int)atomicAdd(ctr, 1u);
  __syncthreads();
  return *sh;
}

constexpr int STG = 32768;
#define WAIT_V(n) asm volatile("s_waitcnt vmcnt(" #n ")" ::: "memory")
#define RAW_BARRIER() do { asm volatile("s_waitcnt lgkmcnt(0)" ::: "memory"); __builtin_amdgcn_s_barrier(); asm volatile("" ::: "memory"); } while (0)
__device__ __forceinline__ void glds16(const u16* g, char* l) {
  __builtin_amdgcn_global_load_lds((const unsigned*)g, (unsigned*)l, 16, 0, 0);
}
template <bool FP8 = false>
__device__ __forceinline__ void gemm_core(f32x4 (&acc)[4][4], const u16* __restrict__ A, long lda,
                                          const u16* __restrict__ Bt, long ldb, int K, u16* smem) {
  const int tid = ltid(), lane = tid & 63, wave = tid >> 6, wr = wave >> 1, wc = wave & 1;
  const int lr = lane & 15, lq = lane >> 4;
  char* base = (char*)smem;
  const int row0 = tid >> 3, kcs = ((tid & 7) ^ ((row0 >> 1) & 7)) * 8;
  const unsigned voA = (unsigned)(row0 * (int)lda + kcs) * 2u, voB = (unsigned)(row0 * (int)ldb + kcs) * 2u;
  const char* Ab = (const char*)A;
  const char* Bb = (const char*)Bt;
  const long a32 = 64 * lda, b32 = 64 * ldb;
  char* dst0 = base + wave * 1024;
  const int f = (lr >> 1) & 7;
  const int aoff = (wr * 64 + lr) * 128, boff = 16384 + (wc * 64 + lr) * 128;
  const int sw0 = ((lq) ^ f) * 16, sw1 = ((4 + lq) ^ f) * 16;
  const int nk = FP8 ? (K >> 7) : (K >> 6);
  RAW_BARRIER();
  {
    char* d = dst0;
#pragma unroll
    for (int i = 0; i < 4; ++i) { glds16((const u16*)(Ab + i * a32 + voA), d + i * 4096); glds16((const u16*)(Bb + i * b32 + voB), d + 16384 + i * 4096); }
    Ab += 128; Bb += 128;
  }
  for (int kt = 0; kt < nk; ++kt) {
    const int cur = kt & 1;
    WAIT_V(0);
    RAW_BARRIER();
    if (kt + 1 < nk) {
      char* d = dst0 + (cur ^ 1) * STG;
#pragma unroll
      for (int i = 0; i < 4; ++i) { glds16((const u16*)(Ab + i * a32 + voA), d + i * 4096); glds16((const u16*)(Bb + i * b32 + voB), d + 16384 + i * 4096); }
      Ab += 128; Bb += 128;
    }
    const char* cs = base + cur * STG;
    if (FP8) {
      typedef int i32x8 __attribute__((ext_vector_type(8)));
      i32x8 a8[4], b8[4];
#pragma unroll
      for (int i = 0; i < 4; ++i) {
        u32x4 al = *(const u32x4*)(cs + aoff + i * 2048 + sw0), ah = *(const u32x4*)(cs + aoff + i * 2048 + sw1);
        u32x4 bl = *(const u32x4*)(cs + boff + i * 2048 + sw0), bh = *(const u32x4*)(cs + boff + i * 2048 + sw1);
        a8[i] = i32x8{(int)al.x, (int)al.y, (int)al.z, (int)al.w, (int)ah.x, (int)ah.y, (int)ah.z, (int)ah.w};
        b8[i] = i32x8{(int)bl.x, (int)bl.y, (int)bl.z, (int)bl.w, (int)bh.x, (int)bh.y, (int)bh.z, (int)bh.w};
      }
#pragma unroll
      for (int mi = 0; mi < 4; ++mi)
#pragma unroll
        for (int ni = 0; ni < 4; ++ni)
          acc[mi][ni] = __builtin_amdgcn_mfma_scale_f32_16x16x128_f8f6f4(a8[mi], b8[ni], acc[mi][ni], 0, 0, 0, 0x7F7F7F7F, 0, 0x7F7F7F7F);
    } else {
#pragma unroll
      for (int ks = 0; ks < 2; ++ks) {
        const int sw = ks ? sw1 : sw0;
        bf16x8 af[4], bf[4];
#pragma unroll
        for (int i = 0; i < 4; ++i) { af[i] = *(const bf16x8*)(cs + aoff + i * 2048 + sw); bf[i] = *(const bf16x8*)(cs + boff + i * 2048 + sw); }
#pragma unroll
        for (int mi = 0; mi < 4; ++mi)
#pragma unroll
          for (int ni = 0; ni < 4; ++ni) acc[mi][ni] = mfma16(af[mi], bf[ni], acc[mi][ni]);
      }
    }
  }
  RAW_BARRIER();
}

template <int FN>
__device__ __forceinline__ void store_tile_bf16(const f32x4 (&acc)[4][4], u16* dst, long ld, u16* smem) {
  const int tid = ltid(), lane = tid & 63, wave = tid >> 6, lr = lane & 15, lq = lane >> 4;
  u16* patch = smem + wave * (64 * 72);
#pragma unroll
  for (int mi = 0; mi < 4; ++mi)
#pragma unroll
    for (int j = 0; j < 4; ++j)
#pragma unroll
      for (int ni = 0; ni < 4; ++ni) {
        float v = acc[mi][ni][j];
        if (FN == 1) v = silu(v);
        if (FN == 2) v = gelu(v);
        patch[(mi * 16 + lq * 4 + j) * 72 + ni * 16 + lr] = f2bf(v);
      }
  __builtin_amdgcn_wave_barrier();
#pragma unroll
  for (int i = 0; i < 8; ++i) {
    const int row = i * 8 + (lane >> 3), ch = (lane & 7) * 8;
    u32x4 v = *(const u32x4*)(patch + row * 72 + ch);
    *(u32x4*)(dst + (long)row * ld + ch) = v;
  }
  __builtin_amdgcn_wave_barrier();
}
__device__ __forceinline__ void store_tile_f32(const f32x4 (&acc)[4][4], float* dst, const float* add, long ld, u16* smem) {
  const int tid = ltid(), lane = tid & 63, wave = tid >> 6, lr = lane & 15, lq = lane >> 4;
  float* patch = (float*)smem + wave * (32 * 68);
#pragma unroll
  for (int hf = 0; hf < 2; ++hf) {
#pragma unroll
    for (int m2 = 0; m2 < 2; ++m2)
#pragma unroll
      for (int j = 0; j < 4; ++j)
#pragma unroll
        for (int ni = 0; ni < 4; ++ni) patch[(m2 * 16 + lq * 4 + j) * 68 + ni * 16 + lr] = acc[hf * 2 + m2][ni][j];
    __builtin_amdgcn_wave_barrier();
#pragma unroll
    for (int i = 0; i < 8; ++i) {
      const int row = i * 4 + (lane >> 4), c4 = (lane & 15) * 4;
      f32x4 v = *(const f32x4*)(patch + row * 68 + c4);
      const long o = (long)(hf * 32 + row) * ld + c4;
      if (add) v += *(const f32x4*)(add + o);
      *(f32x4*)(dst + o) = v;
    }
    __builtin_amdgcn_wave_barrier();
  }
}

constexpr int ALD = 80;
constexpr int ALDK = 80;
template <int NQT, int NS>
struct ASt {
  f32x4 o[NS][4][NQT];
  float m[NS][NQT], l[NS][NQT];
  bf16x8 q[NQT][2];
  __device__ __forceinline__ void reset() {
#pragma unroll
    for (int c = 0; c < NS; ++c)
#pragma unroll
      for (int qi = 0; qi < NQT; ++qi) {
        m[c][qi] = -1e30f; l[c][qi] = 0.f;
#pragma unroll
        for (int di = 0; di < 4; ++di) o[c][di][qi] = f32x4{0.f, 0.f, 0.f, 0.f};
      }
  }
};
struct KVsrc { const u16* k; const u16* v; long ld; };

struct KVregs { u32x4 v0, v1; };
constexpr int KBUF = 8192;
__device__ __forceinline__ void k_dma(const KVsrc& s, int kb, char* kbuf) {
  const int tid = ltid(), wave = tid >> 6;
  const int row = tid >> 3, kcs = ((tid & 7) ^ ((row >> 1) & 7)) * 8;
  __builtin_amdgcn_global_load_lds((const unsigned*)(s.k + (long)(kb + row) * s.ld + kcs), (unsigned*)(kbuf + wave * 1024), 16, 0, 0);
  __builtin_amdgcn_global_load_lds((const unsigned*)(s.k + (long)(kb + row + 32) * s.ld + kcs), (unsigned*)(kbuf + 4096 + wave * 1024), 16, 0, 0);
}
__device__ __forceinline__ void kv_load(const KVsrc& s, int kb, KVregs& R) {
  const int tid = ltid();
  const int row = tid >> 3, col8 = (tid & 7) * 8;
  R.v0 = *(const u32x4*)(s.v + (long)(kb + row) * s.ld + col8);
  R.v1 = *(const u32x4*)(s.v + (long)(kb + row + 32) * s.ld + col8);
}
__device__ __forceinline__ void kv_store(u16* svt, const KVregs& R) {
  const int tid = ltid();
  const int row = tid >> 3, col8 = (tid & 7) * 8;
  *(u32x4*)(svt + row * ALD + col8) = R.v0;
  *(u32x4*)(svt + (row + 32) * ALD + col8) = R.v1;
}

template <int NQT, int NS, bool MASKED, class MaskF>
__device__ __forceinline__ void attn_step(ASt<NQT, NS>& st, const char* sk, const u16* svt, int kb, float c2, MaskF mask) {
  const int lane = ltid() & 63, lr = lane & 15, lq = lane >> 4;
#pragma unroll
  for (int c = 0; c < NS; ++c) {
    f32x4 s[4][NQT];
#pragma unroll
    for (int ki = 0; ki < 4; ++ki) {
      const char* kp = sk + (ki * 16 + lr) * 128;
      const int kf = (lr >> 1) & 7;
      bf16x8 k0 = *(const bf16x8*)(kp + ((((NS == 2 ? 4 * c : 0) + lq) ^ kf) << 4));
      bf16x8 k1 = k0;
      if (NS == 1) k1 = *(const bf16x8*)(kp + (((4 + lq) ^ kf) << 4));
#pragma unroll
      for (int qi = 0; qi < NQT; ++qi) {
        f32x4 z = {0.f, 0.f, 0.f, 0.f};
        z = mfma16(k0, st.q[qi][NS == 1 ? 0 : c], z);
        if (NS == 1) z = mfma16(k1, st.q[qi][1], z);
        s[ki][qi] = z;
      }
    }
    bf16x8 pb[NQT][2];
#pragma unroll
    for (int qi = 0; qi < NQT; ++qi) {
      float mx = st.m[c][qi];
#pragma unroll
      for (int ki = 0; ki < 4; ++ki)
#pragma unroll
        for (int j = 0; j < 4; ++j) {
          float sv = s[ki][qi][j];
          if (MASKED) { sv = mask(kb + ki * 16 + lq * 4 + j, qi) ? sv : -INFINITY; s[ki][qi][j] = sv; }
          mx = fmaxf(mx, sv);
        }
      mx = xmax32(xmax16(mx));
      const float alpha = __builtin_amdgcn_exp2f((st.m[c][qi] - mx) * c2);
      st.m[c][qi] = mx;
      const float mneg = -mx * c2;
      float ls = 0.f;
#pragma unroll
      for (int ki = 0; ki < 4; ++ki)
#pragma unroll
        for (int j = 0; j < 4; ++j) {
          float pv = __builtin_amdgcn_exp2f(__builtin_fmaf(s[ki][qi][j], c2, mneg));
          ls += pv;
          s[ki][qi][j] = pv;
        }
      st.l[c][qi] = st.l[c][qi] * alpha + ls;
#pragma unroll
      for (int di = 0; di < 4; ++di) st.o[c][di][qi] *= alpha;
#pragma unroll
      for (int kk = 0; kk < 2; ++kk) {
        union { unsigned u[4]; bf16x8 v; } pk;
        pk.u[0] = pack2(s[2 * kk][qi][0], s[2 * kk][qi][1]);
        pk.u[1] = pack2(s[2 * kk][qi][2], s[2 * kk][qi][3]);
        pk.u[2] = pack2(s[2 * kk + 1][qi][0], s[2 * kk + 1][qi][1]);
        pk.u[3] = pack2(s[2 * kk + 1][qi][2], s[2 * kk + 1][qi][3]);
        pb[qi][kk] = pk.v;
      }
    }
#pragma unroll
    for (int di = 0; di < 4; ++di)
#pragma unroll
      for (int kk = 0; kk < 2; ++kk) {
        const u16* vp = svt + (kk * 32 + lq * 4 + (lr >> 2)) * ALD + di * 16 + (lr & 3) * 4;
        union { bf16x4 h[2]; bf16x8 v; } vf;
        vf.h[0] = __builtin_amdgcn_ds_read_tr16_b64_v4i16((__attribute__((address_space(3))) bf16x4*)vp);
        vf.h[1] = __builtin_amdgcn_ds_read_tr16_b64_v4i16((__attribute__((address_space(3))) bf16x4*)(vp + 16 * ALD));
#pragma unroll
        for (int qi = 0; qi < NQT; ++qi) st.o[c][di][qi] = mfma16(vf.v, pb[qi][kk], st.o[c][di][qi]);
      }
  }
}

template <int NQT, int NS, class MaskF, class NeedF, class MNeedF>
__device__ __forceinline__ void attn_pass(ASt<NQT, NS>& st, KVsrc src, int kt0, int kt1, float scale, u16* smem, MaskF mask, NeedF need, MNeedF mneed) {
  if (kt0 >= kt1) return;
  const float c2 = scale * 1.4426950408889634f;
  char* sk = (char*)smem;
  u16* svt = smem + KBUF;
  KVregs R;
  __syncthreads();
  k_dma(src, kt0 * 64, sk);
  kv_load(src, kt0 * 64, R);
  kv_store(svt, R);
  asm volatile("s_waitcnt vmcnt(0)" ::: "memory");
  __syncthreads();
  for (int kt = kt0; kt < kt1; ++kt) {
    const int cur = (kt - kt0) & 1;
    const bool more = kt + 1 < kt1;
    if (more) { k_dma(src, (kt + 1) * 64, sk + (cur ^ 1) * KBUF); kv_load(src, (kt + 1) * 64, R); }
    if (need(kt)) {
      if (mneed(kt)) attn_step<NQT, NS, true>(st, sk + cur * KBUF, svt + cur * 64 * ALD, kt * 64, c2, mask);
      else attn_step<NQT, NS, false>(st, sk + cur * KBUF, svt + cur * 64 * ALD, kt * 64, c2, mask);
    }
    if (more) kv_store(svt + (cur ^ 1) * 64 * ALD, R);
    asm volatile("s_waitcnt vmcnt(0)" ::: "memory");
    __syncthreads();
  }
}
__device__ __forceinline__ float quadsum_(float v, int lane) { return xsum32(xsum16(v)); }
#define quadsum(v) quadsum_((v), lane)

__device__ __forceinline__ int remap_row(int kind, int n) {
  if (kind == 1) return n < 3200 ? n : (n < 3212 ? 3968 + (n - 3200) : n - 12);
  if (kind == 2) { int c = n & 255, g = n >> 8; return 32 * (c >> 4) + 16 * g + (c & 15); }
  return n;
}
struct XTile { const float* src; u16* dst; int N, Kd, remap, k0, n0; bool f8; };
__device__ __forceinline__ void xpose_load(const XTile& t, f32x4 (&v)[4]) {
  const int tid = ltid();
#pragma unroll
  for (int i = 0; i < 4; ++i) {
    int kk = (tid >> 4) + i * 16, nn = (tid & 15) * 4;
    int n = t.n0 + nn;
    v[i] = f32x4{0.f, 0.f, 0.f, 0.f};
    if (n < t.N) v[i] = *(const f32x4*)(t.src + (long)(t.k0 + kk) * t.N + n);
  }
}
__device__ __forceinline__ void xpose_finish(const XTile& t, const f32x4 (&v)[4], float* tile) {
  const int tid = ltid();
  __syncthreads();
#pragma unroll
  for (int i = 0; i < 4; ++i) {
    int kk = (tid >> 4) + i * 16, nn = (tid & 15) * 4;
    tile[kk * 65 + nn] = v[i][0]; tile[kk * 65 + nn + 1] = v[i][1]; tile[kk * 65 + nn + 2] = v[i][2]; tile[kk * 65 + nn + 3] = v[i][3];
  }
  __syncthreads();
  int nn = tid >> 2, ks = (tid & 3) * 16;
  int n = t.n0 + nn;
  if (n < t.N) {
    int drow = remap_row(t.remap, n);
    if (t.f8) {
      unsigned w8[4];
#pragma unroll
      for (int i = 0; i < 4; ++i)
        w8[i] = pack4_fp8(32.f * tile[(ks + 4 * i) * 65 + nn], 32.f * tile[(ks + 4 * i + 1) * 65 + nn], 32.f * tile[(ks + 4 * i + 2) * 65 + nn], 32.f * tile[(ks + 4 * i + 3) * 65 + nn]);
      *(uint4*)((char*)t.dst + (long)drow * t.Kd + t.k0 + ks) = uint4{w8[0], w8[1], w8[2], w8[3]};
    } else {
      unsigned w[8];
#pragma unroll
      for (int i = 0; i < 8; ++i) w[i] = pack2(tile[(ks + 2 * i) * 65 + nn], tile[(ks + 2 * i + 1) * 65 + nn]);
      u16* d = t.dst + (long)drow * t.Kd + t.k0 + ks;
      *(uint4*)d = uint4{w[0], w[1], w[2], w[3]};
      *(uint4*)(d + 8) = uint4{w[4], w[5], w[6], w[7]};
    }
  }
}

template <bool OUT_BF16>
__device__ __forceinline__ void rmsnorm_row(const float* src, const float* g, void* dst, unsigned char* dst8 = nullptr) {
  const int lane = ltid() & 63;
  float4 v[4];
  float ss = 0.f;
#pragma unroll
  for (int k = 0; k < 4; ++k) {
    v[k] = *(const float4*)(src + k * 256 + lane * 4);
    ss += v[k].x * v[k].x + v[k].y * v[k].y + v[k].z * v[k].z + v[k].w * v[k].w;
  }
  ss += __int_as_float(__builtin_amdgcn_update_dpp(0, __float_as_int(ss), 0xB1, 0xf, 0xf, true));
  ss += __int_as_float(__builtin_amdgcn_update_dpp(0, __float_as_int(ss), 0x4E, 0xf, 0xf, true));
  ss += __int_as_float(__builtin_amdgcn_update_dpp(0, __float_as_int(ss), 0x141, 0xf, 0xf, true));
  ss += __int_as_float(__builtin_amdgcn_update_dpp(0, __float_as_int(ss), 0x140, 0xf, 0xf, true));
  ss = xsum32(xsum16(ss));
  float rs = rsqrtf(ss * (1.f / 1024.f) + 1e-6f);
#pragma unroll
  for (int k = 0; k < 4; ++k) {
    float4 gg = *(const float4*)(g + k * 256 + lane * 4);
    float a = v[k].x * rs * gg.x, b = v[k].y * rs * gg.y, c = v[k].z * rs * gg.z, d = v[k].w * rs * gg.w;
    if (OUT_BF16) {
      uint2 o2; o2.x = pack2(a, b); o2.y = pack2(c, d);
      *(uint2*)((u16*)dst + k * 256 + lane * 4) = o2;
      if (dst8) *(unsigned*)(dst8 + k * 256 + lane * 4) = pack4_fp8(a, b, c, d);
    } else {
      *(float4*)((float*)dst + k * 256 + lane * 4) = float4{a, b, c, d};
    }
  }
}

__device__ void phase_setup(PP p, char* smem) {
  const int tid = ltid(), lane = tid & 63, wave = tid >> 6;
  const long gtid = (long)blockIdx.x * 256 + tid, gsz = (long)gridDim.x * 256;
  float* tile = (float*)smem;
  if ((int)blockIdx.x >= (int)gridDim.x - 64) {
    const int it = blockIdx.x - (gridDim.x - 64);
    const int lk = it >> 4, kc = it & 15;
    const float* pe = p->nsa_pe + (long)lk * 2048 + kc * 128 + wave * 32;
    const float* w1 = p->nsa_w1 + ((long)lk * 2048 + kc * 128 + wave * 32) * 256 + lane;
    float s0 = 0.f, s1 = 0.f, s2 = 0.f, s3 = 0.f;
#pragma unroll 8
    for (int k = 0; k < 32; ++k) {
      float pv = pe[k];
      s0 += pv * w1[(long)k * 256]; s1 += pv * w1[(long)k * 256 + 64]; s2 += pv * w1[(long)k * 256 + 128]; s3 += pv * w1[(long)k * 256 + 192];
    }
    tile[wave * 256 + lane] = s0; tile[wave * 256 + 64 + lane] = s1; tile[wave * 256 + 128 + lane] = s2; tile[wave * 256 + 192 + lane] = s3;
    __syncthreads();
    WSP(float, O_BPE)[(lk * 16 + kc) * 256 + tid] = tile[tid] + tile[256 + tid] + tile[512 + tid] + tile[768 + tid];
    __syncthreads();
  }
  {
    auto decode = [&](int it, XTile& t) {
      int l = it / 3288, r = it % 3288;
      int nt; t.remap = 0; t.f8 = false;
      if (r < 1008) { t.src = p->w_in + (long)l * 1024 * 3980; t.N = 3980; t.Kd = 1024; t.dst = WSP(u16, O_WCAT + l * SZ_WCAT); t.remap = 1; nt = 63; }
      else if ((r -= 1008) < 1280) { t.src = p->w_merge + (long)l * 1024 * 5120; t.N = 5120; t.Kd = 1024; t.dst = (u16*)(p->ws + O_WM8 + l * SZ_WM8); t.f8 = true; nt = 80; }
      else if ((r -= 1280) < 320) { int n = r / 64; r %= 64; t.src = p->w_branch + (long)(l * 5 + n) * 256 * 1024; t.N = 1024; t.Kd = 256; t.dst = WSP(u16, O_WBT + l * SZ_WBT) + (long)n * 1024 * 256; nt = 16; }
      else if ((r -= 320) < 256) { t.src = p->w_out + (long)l * 1024 * 1024; t.N = 1024; t.Kd = 1024; t.dst = WSP(u16, O_WOT + l * SZ_WOT); nt = 16; }
      else if ((r -= 256) < 32) { t.src = p->w_glu + (long)l * 256 * 512; t.N = 512; t.Kd = 256; t.dst = WSP(u16, O_WGT + l * SZ_WGT); t.remap = 2; nt = 8; }
      else if ((r -= 32) < 128) { t.src = p->w_mem_kv + (long)l * 1024 * 512; t.N = 512; t.Kd = 1024; t.dst = WSP(u16, O_WKVT + l * SZ_WKVT); nt = 8; }
      else if ((r -= 128) < 256) { int kv = r / 128; r %= 128; t.src = p->nsa_w1 + (long)(l * 2 + kv) * 2048 * 256; t.N = 256; t.Kd = 2048; t.dst = WSP(u16, O_W1T + l * SZ_W1T) + (long)kv * 256 * 2048; nt = 4; }
      else { r -= 256; int kv = r / 4; r %= 4; t.src = p->nsa_w2 + (long)(l * 2 + kv) * 256 * 64; t.N = 64; t.Kd = 256; t.dst = WSP(u16, O_W2T + l * SZ_W2T) + (long)kv * 128 * 256; nt = 1; }
      t.k0 = (r / nt) * 64; t.n0 = (r % nt) * 64;
    };
    XTile tc, tn;
    f32x4 vc[4], vn[4];
    int it = blockIdx.x;
    if (it < 6576) { decode(it, tc); xpose_load(tc, vc); }
    for (; it < 6576; it += gridDim.x) {
      const int nx = it + gridDim.x;
      if (nx < 6576) { decode(nx, tn); xpose_load(tn, vn); }
      xpose_finish(tc, vc, tile);
      tc = tn;
#pragma unroll
      for (int i = 0; i < 4; ++i) vc[i] = vn[i];
    }
  }
  for (long i = gtid; i < 2 * 116 * 1024; i += gsz) { int l = (int)(i / (116 * 1024)); long r = i % (116 * 1024); WSP(u16, O_WCAT + l * SZ_WCAT)[(long)3980 * 1024 + r] = 0; }
  for (long i = gtid; i < 4 * 64 * 256; i += gsz) { int lk = (int)(i / (64 * 256)); long r = i % (64 * 256); WSP(u16, O_W2T)[(long)lk * 128 * 256 + 64 * 256 + r] = 0; }
  for (long i = gtid; i < 4096; i += gsz) { WSP(u16, O_KC)[(long)8 * 2048 * 64 + i] = 0; WSP(u16, O_VC)[(long)8 * 2048 * 64 + i] = 0; }
  if (gtid < 64) WSP(unsigned, O_CTR)[gtid] = 0u;
  for (int r0 = blockIdx.x * 4 + wave; r0 < T + 4096; r0 += gridDim.x * 8) {
#pragma unroll
    for (int u = 0; u < 2; ++u) {
      const int r = r0 + u * (int)gridDim.x * 4;
      if (r < T) rmsnorm_row<true>(p->x + (long)r * 1024, p->norm_g, WSP(u16, O_H) + (long)r * 1024, (unsigned char*)(p->ws + O_H8) + (long)r * 1024);
      else if (r < T + 4096) { int rr = r - T; int l = rr >> 11; int m = rr & 2047; rmsnorm_row<true>(p->mem + (long)m * 1024, p->mem_norm_g + l * 1024, WSP(u16, O_MEMH) + (long)rr * 1024); }
    }
  }
  for (long i = gtid; i < 2048 * 48; i += gsz) {
    int s = (int)(i / 48), e = (int)(i % 48);
    float fr = e < 32 ? (float)e / 32.f : (float)(e - 32) / 16.f;
    float inv = exp2f(-fr * 13.287712379549449f);
    float ang = (float)s * inv;
    float sn, cs; sincosf(ang, &sn, &cs);
    if (e < 32) WSP(float2, O_ROPE32)[s * 32 + e] = float2{cs, sn};
    else WSP(float2, O_ROPE16)[s * 16 + (e - 32)] = float2{cs, sn};
  }
  for (long i = gtid; i < 2048; i += gsz) {
    int l = (int)(i >> 10), gn = (int)(i & 1023), g = gn >> 6;
    float lr = p->s5_lre[i], li = p->s5_lim[i];
    float dt = expf(p->s5_logdt[l * 16 + g]);
    float mag = expf(lr * dt);
    float sn, cs; sincosf(li * dt, &sn, &cs);
    float are = mag * cs, aim = mag * sn;
    float den = lr * lr + li * li;
    float nre = are - 1.f, nim = aim;
    float zre = (nre * lr + nim * li) / den, zim = (nim * lr - nre * li) / den;
    float* sp = WSP(float, O_S5P + l * SZ_S5P);
    sp[gn] = are; sp[1024 + gn] = aim;
    float magL = expf(lr * dt * 64.f);
    float snL, csL; sincosf(li * dt * 64.f, &snL, &csL);
    sp[2048 + gn] = magL * csL; sp[3072 + gn] = magL * snL;
    for (int q = 0; q < 16; ++q) {
      float br = p->s5_bre[i * 16 + q], bi = p->s5_bim[i * 16 + q];
      sp[4096 + gn * 16 + q] = zre * br - zim * bi;
      sp[4096 + 16384 + gn * 16 + q] = zre * bi + zim * br;
    }
  }
  if (gtid < 2) {
    int l = (int)gtid;
    const float* dl = p->diff_lambda + l * 128;
    float s1 = 0.f, s2 = 0.f;
    for (int i = 0; i < 32; ++i) { s1 += dl[i] * dl[32 + i]; s2 += dl[64 + i] * dl[96 + i]; }
    float li = 0.8f - 0.6f * expf(-0.3f * (float)l);
    WSP(float, O_LAM)[l * 2] = expf(s1) - expf(s2) + li;
    WSP(float, O_LAM)[l * 2 + 1] = li;
  }
}

__device__ __forceinline__ void epi_proj(PP p, f32x4 (&acc)[4][4], int trow0, int tcol0, u16* smem) {
  const int lane = ltid() & 63, wave = ltid() >> 6, wr = wave >> 1, wc = wave & 1, lr = lane & 15, lq = lane >> 4;
  const int row0 = trow0 + wr * 64, cc = (tcol0 + wc * 64) >> 6;
  const int b = row0 >> 11, s0 = row0 & 2047;
  int kind = 0; u16* dst = nullptr; long ld = 64;
  auto headbuf = [&](size_t off, int h) { dst = WSP(u16, off) + ((long)((b * 4 + h) * 2048 + s0)) * 64; ld = 64; };
  auto onebuf = [&](size_t off) { dst = WSP(u16, off) + ((long)(b * 2048 + s0)) * 64; ld = 64; };
  auto szbuf = [&](int n, int h) { dst = WSP(u16, O_SZ) + (long)n * T * 256 + (long)row0 * 256 + h * 64; ld = 256; kind = 3; };
  if (cc < 4) { kind = 1; headbuf(O_DQ, cc); }
  else if (cc < 8) { kind = 1; headbuf(O_DK, cc - 4); }
  else if (cc < 12) { headbuf(O_DV, cc - 8); }
  else if (cc < 16) { szbuf(0, cc - 12); }
  else if (cc < 20) { kind = 2; headbuf(O_LQ, cc - 16); }
  else if (cc < 24) { kind = 2; headbuf(O_LK, cc - 20); }
  else if (cc < 28) { headbuf(O_LV, cc - 24); }
  else if (cc < 32) { szbuf(1, cc - 28); }
  else if (cc < 36) { kind = 4; }
  else if (cc < 40) { szbuf(2, cc - 36); }
  else if (cc < 44) { headbuf(O_NQ, cc - 40); }
  else if (cc == 44) { onebuf(O_KC); }
  else if (cc == 45) { onebuf(O_VC); }
  else if (cc == 46) { kind = 2; onebuf(O_KSR); }
  else if (cc == 47) { onebuf(O_VS); }
  else if (cc == 48) { kind = 2; onebuf(O_KWR); }
  else if (cc == 49) { onebuf(O_VW); }
  else if (cc < 54) { szbuf(3, cc - 50); }
  else if (cc < 58) { headbuf(O_MQ, cc - 54); }
  else if (cc < 62) { szbuf(4, cc - 58); }
  else if (cc == 62) { kind = 5; }
  else { kind = 6; }
  if (kind == 6) return;
  if (kind == 4) {
    float* su = WSP(float, O_SU) + (long)row0 * 256 + (cc - 32) * 64;
    store_tile_f32(acc, su, nullptr, 256, smem);
    return;
  }
  if (kind == 5) {
    float* ng = WSP(float, O_NG) + (long)row0 * 12;
    if (lr < 12) {
#pragma unroll
      for (int mi = 0; mi < 4; ++mi)
#pragma unroll
        for (int j = 0; j < 4; ++j) ng[(mi * 16 + lq * 4 + j) * 12 + lr] = sigm(acc[mi][0][j]);
    }
    return;
  }
  if (kind == 3) { store_tile_bf16<1>(acc, dst, ld, smem); return; }
  if (kind == 1) {
    const float2* tab = WSP(float2, O_ROPE16);
#pragma unroll
    for (int mi = 0; mi < 4; ++mi)
#pragma unroll
      for (int j = 0; j < 4; ++j) {
        float2 cs = tab[(s0 + mi * 16 + lq * 4 + j) * 16 + lr];
#pragma unroll
        for (int ni = 0; ni < 4; ni += 2) {
          float x1 = acc[mi][ni][j], x2 = acc[mi][ni + 1][j];
          acc[mi][ni][j] = x1 * cs.x - x2 * cs.y;
          acc[mi][ni + 1][j] = x2 * cs.x + x1 * cs.y;
        }
      }
  } else if (kind == 2) {
    const float2* tab = WSP(float2, O_ROPE32);
#pragma unroll
    for (int mi = 0; mi < 4; ++mi)
#pragma unroll
      for (int j = 0; j < 4; ++j)
#pragma unroll
        for (int ni = 0; ni < 2; ++ni) {
          float2 cs = tab[(s0 + mi * 16 + lq * 4 + j) * 32 + ni * 16 + lr];
          float x1 = acc[mi][ni][j], x2 = acc[mi][ni + 2][j];
          acc[mi][ni][j] = x1 * cs.x - x2 * cs.y;
          acc[mi][ni + 2][j] = x2 * cs.x + x1 * cs.y;
        }
  }
  store_tile_bf16<0>(acc, dst, ld, smem);
}

__device__ void phase_gemm1(PP p, int l, u16* smem) {
  const int wave = ltid() >> 6, wr = wave >> 1, wc = wave & 1;
  const int ntile = 4096;
  for (int t = blockIdx.x; t < ntile; t += gridDim.x) {
    p = getP();
    f32x4 acc[4][4];
#pragma unroll
    for (int i = 0; i < 4; ++i)
#pragma unroll
      for (int j = 0; j < 4; ++j) acc[i][j] = f32x4{0.f, 0.f, 0.f, 0.f};
    {
      int rt, ct;
      if (gridDim.x == 512) { const int xcd = t & 7, slot = (t >> 3) & 63, rnd = t >> 9; rt = rnd * 16 + ((xcd >> 2) << 3) + (slot >> 3); ct = ((xcd & 3) << 3) + (slot & 7); }
      else { rt = t >> 5; ct = t & 31; }
      gemm_core(acc, WSP(u16, O_H) + (long)rt * 128 * 1024, 1024, WSP(u16, O_WCAT + l * SZ_WCAT) + (long)ct * 128 * 1024, 1024, 1024, smem);
      epi_proj(p, acc, rt * 128, ct * 128, smem);
    }
  }
}

__device__ void item_diff(PP p, int l, int id, u16* smem, bool g_dry) {
  const int lane = ltid() & 63, wave = ltid() >> 6, lr = lane & 15, lq = lane >> 4;
  const int qb = 31 - (id >> 5), bh = id & 31, h = bh & 3, b = bh >> 2;
  const int s = qb * 64 + wave * 16 + lr;
  ASt<1, 2> st;
  st.reset();
  const u16* qp = WSP(u16, O_DQ) + ((long)(bh * 2048 + s)) * 64 + lq * 8;
  st.q[0][0] = *(const bf16x8*)qp;
  st.q[0][1] = *(const bf16x8*)(qp + 32);
  KVsrc src{WSP(u16, O_DK) + (long)bh * 2048 * 64, WSP(u16, O_DV) + (long)bh * 2048 * 64, 64};
  attn_pass<1, 2>(st, src, 0, qb + 1, 0.17677669529663687f, smem, [&](int key, int qi) { return key <= s; }, [&](int kt) { return true; }, [&](int kt) { return kt == qb; });
  const float lam = WSP(float, O_LAM)[l * 2], lam_init = WSP(float, O_LAM)[l * 2 + 1];
  float i0 = 1.f / quadsum(st.l[0][0]), i1 = lam / quadsum(st.l[1][0]);
  float ss = 0.f;
#pragma unroll
  for (int di = 0; di < 4; ++di)
#pragma unroll
    for (int j = 0; j < 4; ++j) {
      float v = st.o[0][di][0][j] * i0 - st.o[1][di][0][j] * i1;
      st.o[0][di][0][j] = v;
      ss += v * v;
    }
  ss = quadsum(ss);
  float rs = rsqrtf(ss * (1.f / 64.f) + 1e-6f) * (1.f - lam_init);
  u16* zb = WSP(u16, O_SZ) + ((long)(b * 2048 + s)) * 256 + h * 64;
#pragma unroll
  for (int di = 0; di < 4; ++di) {
    int d0 = di * 16 + lq * 4;
    uint2 zz = *(const uint2*)(zb + d0);
    float4 g = *(const float4*)(p->diff_subln_g + l * 64 + d0);
    float o0 = st.o[0][di][0][0] * rs * g.x * bf2f((u16)(zz.x & 0xffff));
    float o1 = st.o[0][di][0][1] * rs * g.y * bf2f((u16)(zz.x >> 16));
    float o2 = st.o[0][di][0][2] * rs * g.z * bf2f((u16)(zz.y & 0xffff));
    float o3 = st.o[0][di][0][3] * rs * g.w * bf2f((u16)(zz.y >> 16));
    uint2 ov; ov.x = pack2(o0, o1); ov.y = pack2(o2, o3);
    if (!g_dry) *(uint2*)(zb + d0) = ov;
  }
}

__device__ void item_dilated(PP p, int id, u16* smem) {
  const int lane = ltid() & 63, wave = ltid() >> 6, lr = lane & 15, lq = lane >> 4;
  const int pat = id >> 9; int r = id & 511;
  const int dil = pat == 0 ? 1 : (pat == 1 ? 4 : 16);
  const int nblk = 16 / dil;
  const int blk = r % nblk; r /= nblk;
  const int res = r % dil; r /= dil;
  const int bh = r;
  const int b = bh >> 2, h = bh & 3;
  int qi_idx[2], spos[2];
#pragma unroll
  for (int qi = 0; qi < 2; ++qi) { qi_idx[qi] = blk * 128 + wave * 32 + qi * 16 + lr; spos[qi] = qi_idx[qi] * dil + res; }
  ASt<2, 1> st;
  st.reset();
#pragma unroll
  for (int qi = 0; qi < 2; ++qi) {
    const u16* qp = WSP(u16, O_LQ) + ((long)(bh * 2048 + spos[qi])) * 64 + lq * 8;
    st.q[qi][0] = *(const bf16x8*)qp;
    st.q[qi][1] = *(const bf16x8*)(qp + 32);
  }
  KVsrc src{WSP(u16, O_LK) + ((long)(bh * 2048 + res)) * 64, WSP(u16, O_LV) + ((long)(bh * 2048 + res)) * 64, (long)dil * 64};
  const int kt0 = blk * 2 - 2 < 0 ? 0 : blk * 2 - 2, kt1 = blk * 2 + 2;
  const int imin = blk * 128 + wave * 32, imax = imin + 31;
  attn_pass<2, 1>(st, src, kt0, kt1, 0.125f, smem,
                  [&](int key, int qi) { return key <= qi_idx[qi] && key >= qi_idx[qi] - 128; },
                  [&](int kt) { return kt * 64 <= imax && kt * 64 + 63 >= imin - 128; },
                  [&](int kt) { return !(kt * 64 + 63 <= imin && kt * 64 >= imax - 128); });
#pragma unroll
  for (int qi = 0; qi < 2; ++qi) {
    float lt = quadsum(st.l[0][qi]);
    float inv = 1.f / lt;
    long tok = (long)b * 2048 + spos[qi];
    u16* ob = WSP(u16, O_DILO) + (long)pat * T * 256 + tok * 256 + h * 64;
#pragma unroll
    for (int di = 0; di < 4; ++di) {
      uint2 ov; ov.x = pack2(st.o[0][di][qi][0] * inv, st.o[0][di][qi][1] * inv); ov.y = pack2(st.o[0][di][qi][2] * inv, st.o[0][di][qi][3] * inv);
      *(uint2*)(ob + di * 16 + lq * 4) = ov;
    }
    if (lq == 0) WSP(float, O_DLSE)[(long)pat * T * 4 + tok * 4 + h] = st.m[0][qi] * 0.125f + __logf(lt);
  }
}

__device__ void item_mem(PP p, int l, int id, u16* smem, bool g_dry) {
  const int lane = ltid() & 63, wave = ltid() >> 6, lr = lane & 15, lq = lane >> 4;
  const int qb = id & 15, bh = id >> 4, b = bh >> 2, h = bh & 3;
  int spos[2];
  ASt<2, 1> st;
  st.reset();
#pragma unroll
  for (int qi = 0; qi < 2; ++qi) {
    spos[qi] = qb * 128 + wave * 32 + qi * 16 + lr;
    const u16* qp = WSP(u16, O_MQ) + ((long)(bh * 2048 + spos[qi])) * 64 + lq * 8;
    st.q[qi][0] = *(const bf16x8*)qp;
    st.q[qi][1] = *(const bf16x8*)(qp + 32);
  }
  KVsrc src{WSP(u16, O_MEMK) + (long)l * 8 * 4 * 256 * 64 + (long)bh * 256 * 64, WSP(u16, O_MEMV) + (long)l * 8 * 4 * 256 * 64 + (long)bh * 256 * 64, 64};
  attn_pass<2, 1>(st, src, 0, 4, 0.125f, smem, [&](int key, int qi) { return true; }, [&](int kt) { return true; }, [&](int kt) { return false; });
#pragma unroll
  for (int qi = 0; qi < 2; ++qi) {
    float inv = 1.f / quadsum(st.l[0][qi]);
    u16* zb = WSP(u16, O_SZ) + (long)4 * T * 256 + ((long)(b * 2048 + spos[qi])) * 256 + h * 64;
#pragma unroll
    for (int di = 0; di < 4; ++di) {
      int d0 = di * 16 + lq * 4;
      uint2 zz = *(const uint2*)(zb + d0);
      uint2 ov;
      ov.x = pack2(st.o[0][di][qi][0] * inv * bf2f((u16)(zz.x & 0xffff)), st.o[0][di][qi][1] * inv * bf2f((u16)(zz.x >> 16)));
      ov.y = pack2(st.o[0][di][qi][2] * inv * bf2f((u16)(zz.y & 0xffff)), st.o[0][di][qi][3] * inv * bf2f((u16)(zz.y >> 16)));
      if (!g_dry) *(uint2*)(zb + d0) = ov;
    }
  }
}

template <int NQT>
__device__ void item_nsa(PP p, int id, u16* smem, float* imp, unsigned* selm, float* resp, bool g_dry) {
  constexpr int NQ = NQT * 16;
  constexpr int NBLK = 2048 / NQ;
  const int tid = ltid(), lane = tid & 63, wave = tid >> 6, lr = lane & 15, lq = lane >> 4;
  const int blk = NBLK - 1 - (id >> 3), b = id & 7;
  const int s0 = blk * NQ, qblk = s0 >> 6, h = wave;
  int spos[NQT];
#pragma unroll
  for (int qi = 0; qi < NQT; ++qi) spos[qi] = s0 + qi * 16 + lr;
  const float* gp = WSP(float, O_NG) + ((long)b * 2048) * 12 + h * 3;
  ASt<NQT, 1> st;
  st.reset();
#pragma unroll
  for (int qi = 0; qi < NQT; ++qi) {
    const u16* qp = WSP(u16, O_NQ) + ((long)((b * 4 + h) * 2048 + spos[qi])) * 64 + lq * 8;
    st.q[qi][0] = *(const bf16x8*)qp;
    st.q[qi][1] = *(const bf16x8*)(qp + 32);
  }
  int imaxc = (s0 + NQ - 1 - 31) >> 4;
  if (imaxc > 126) imaxc = 126;
  const int kt1c = imaxc < 0 ? 0 : (imaxc >> 6) + 1;
  auto cmask = [&](int key, int qi) { return key < 127 && 16 * key + 31 <= spos[qi]; };
  KVsrc csrc{WSP(u16, O_KCMP) + (long)b * 128 * 64, WSP(u16, O_VCMP) + (long)b * 128 * 64, 64};
  attn_pass<NQT, 1>(st, csrc, 0, kt1c, 0.125f, smem, cmask, [&](int kt) { return true; }, [&](int kt) { return true; });
  float invl[NQT];
#pragma unroll
  for (int qi = 0; qi < NQT; ++qi) {
    float lt = quadsum(st.l[0][qi]);
    invl[qi] = lt > 0.f ? 1.f / lt : 0.f;
    float sc = gp[spos[qi] * 12 + 0] * invl[qi];
#pragma unroll
    for (int di = 0; di < 4; ++di)
#pragma unroll
      for (int j = 0; j < 4; ++j) resp[((di * NQT + qi) * 4 + j) * 256 + tid] = st.o[0][di][qi][j] * sc;
  }
  unsigned selq[NQT];
#pragma unroll
  for (int qi = 0; qi < NQT; ++qi) selq[qi] = (qblk == 31) ? 0xffffffffu : ((1u << (qblk + 1)) - 1u);
  if (qblk >= 16) {
    for (int i = tid; i < NQ * 33; i += 256) imp[i] = 0.f;
    if (tid < NQ) selm[tid] = 0u;
    __syncthreads();
    for (int hh = 0; hh < 4; ++hh) {
      if (wave == hh) {
#pragma unroll
        for (int kt = 0; kt < 2; ++kt) {
          const char* sk = (const char*)smem + kt * KBUF;
#pragma unroll
          for (int ki = 0; ki < 4; ++ki) {
            const char* kp = sk + (ki * 16 + lr) * 128;
            const int kf = (lr >> 1) & 7;
            bf16x8 k0 = *(const bf16x8*)(kp + ((lq ^ kf) << 4)), k1 = *(const bf16x8*)(kp + (((4 + lq) ^ kf) << 4));
#pragma unroll
            for (int qi = 0; qi < NQT; ++qi) {
              f32x4 z = {0.f, 0.f, 0.f, 0.f};
              z = mfma16(k0, st.q[qi][0], z);
              z = mfma16(k1, st.q[qi][1], z);
              float pr[4];
#pragma unroll
              for (int j = 0; j < 4; ++j) {
                int key = kt * 64 + ki * 16 + lq * 4 + j;
                pr[j] = cmask(key, qi) ? __expf((z[j] - st.m[0][qi]) * 0.125f) * invl[qi] : 0.f;
              }
              float* ip = imp + (qi * 16 + lr) * 33 + kt * 16 + ki * 4 + lq;
              ip[0] += 2.f * (pr[0] + pr[1] + pr[2]) + pr[3];
              __builtin_amdgcn_wave_barrier();
              ip[1] += pr[3];
              __builtin_amdgcn_wave_barrier();
            }
          }
        }
      }
      __syncthreads();
    }
    {
      constexpr int TPQ = 256 / NQ;
      constexpr int JPT = 32 / TPQ;
      int q = tid / TPQ;
      unsigned bits = 0u;
      if ((tid % TPQ) == 0) bits = 1u | (1u << qblk) | (1u << (qblk - 1));
#pragma unroll
      for (int e = 0; e < JPT; ++e) {
        int j = (tid % TPQ) * JPT + e;
        if (j >= 1 && j <= qblk - 2) {
          float v = imp[q * 33 + j];
          int rank = 0;
          for (int j2 = 1; j2 <= qblk - 2; ++j2) {
            float v2 = imp[q * 33 + j2];
            rank += (v2 > v || (v2 == v && j2 < j)) ? 1 : 0;
          }
          if (rank < 13) bits |= 1u << j;
        }
      }
      if (bits) atomicOr(&selm[q], bits);
    }
    __syncthreads();
#pragma unroll
    for (int qi = 0; qi < NQT; ++qi) selq[qi] = selm[qi * 16 + lr];
  }
#pragma unroll
  for (int qi = 0; qi < NQT; ++qi) {
    const float2* tab = WSP(float2, O_ROPE32) + spos[qi] * 32 + lq * 8;
    bf16x8 a = st.q[qi][0], c2 = st.q[qi][1];
#pragma unroll
    for (int j = 0; j < 8; ++j) {
      float2 cs = tab[j];
      float x1 = bf2f((u16)a[j]), x2 = bf2f((u16)c2[j]);
      a[j] = (short)f2bf(x1 * cs.x - x2 * cs.y);
      c2[j] = (short)f2bf(x2 * cs.x + x1 * cs.y);
    }
    st.q[qi][0] = a; st.q[qi][1] = c2;
  }
  st.reset();
  {
    KVsrc ssrc{WSP(u16, O_KSR) + (long)b * 2048 * 64, WSP(u16, O_VS) + (long)b * 2048 * 64, 64};
    unsigned selany = 0u;
#pragma unroll
    for (int qi = 0; qi < NQT; ++qi) selany |= selq[qi];
    attn_pass<NQT, 1>(st, ssrc, 0, qblk + 1, 0.125f, smem,
                      [&](int key, int qi) { return ((selq[qi] >> (key >> 6)) & 1u) && key <= spos[qi]; },
                      [&](int kt) { return __ballot(((selany >> kt) & 1u) != 0u) != 0ull; },
                      [&](int kt) { return true; });
#pragma unroll
    for (int qi = 0; qi < NQT; ++qi) {
      float lt = quadsum(st.l[0][qi]);
      float sc = lt > 0.f ? gp[spos[qi] * 12 + 1] / lt : 0.f;
#pragma unroll
      for (int di = 0; di < 4; ++di)
#pragma unroll
        for (int j = 0; j < 4; ++j) resp[((di * NQT + qi) * 4 + j) * 256 + tid] += st.o[0][di][qi][j] * sc;
    }
  }
  st.reset();
  {
    KVsrc wsrc{WSP(u16, O_KWR) + (long)b * 2048 * 64, WSP(u16, O_VW) + (long)b * 2048 * 64, 64};
    int lo = s0 - 511; if (lo < 0) lo = 0;
    attn_pass<NQT, 1>(st, wsrc, lo >> 6, qblk + 1, 0.125f, smem,
                      [&](int key, int qi) { return key <= spos[qi] && key > spos[qi] - 512; },
                      [&](int kt) { return true; },
                      [&](int kt) { return !(kt * 64 + 63 <= s0 && kt * 64 > s0 + NQ - 1 - 512); });
#pragma unroll
    for (int qi = 0; qi < NQT; ++qi) {
      float lt = quadsum(st.l[0][qi]);
      float sc = lt > 0.f ? gp[spos[qi] * 12 + 2] / lt : 0.f;
#pragma unroll
      for (int di = 0; di < 4; ++di)
#pragma unroll
        for (int j = 0; j < 4; ++j) resp[((di * NQT + qi) * 4 + j) * 256 + tid] += st.o[0][di][qi][j] * sc;
    }
  }
#pragma unroll
  for (int qi = 0; qi < NQT; ++qi) {
    u16* zb = WSP(u16, O_SZ) + (long)3 * T * 256 + ((long)b * 2048 + spos[qi]) * 256 + h * 64;
#pragma unroll
    for (int di = 0; di < 4; ++di) {
      int d0 = di * 16 + lq * 4;
      uint2 zz = *(const uint2*)(zb + d0);
      uint2 ov;
      const float* rp = resp + ((di * NQT + qi) * 4) * 256 + tid;
      ov.x = pack2(rp[0] * bf2f((u16)(zz.x & 0xffff)), rp[256] * bf2f((u16)(zz.x >> 16)));
      ov.y = pack2(rp[512] * bf2f((u16)(zz.y & 0xffff)), rp[768] * bf2f((u16)(zz.y >> 16)));
      if (!g_dry) *(uint2*)(zb + d0) = ov;
    }
  }
}

__device__ void item_s5_local(PP p, int l, int id) {
  const int lane = ltid() & 63, wave = ltid() >> 6;
  const int u = id * 4 + wave;
  const int c = u & 31, g = (u >> 5) & 15, b = u >> 9;
  const float* sp = WSP(float, O_S5P + l * SZ_S5P);
  const int gn = g * 64 + lane;
  const float are = sp[gn], aim = sp[1024 + gn];
  float bre[16], bim[16];
#pragma unroll
  for (int q = 0; q < 4; ++q) {
    float4 t1 = *(const float4*)(sp + 4096 + gn * 16 + q * 4);
    float4 t2 = *(const float4*)(sp + 4096 + 16384 + gn * 16 + q * 4);
    bre[q * 4] = t1.x; bre[q * 4 + 1] = t1.y; bre[q * 4 + 2] = t1.z; bre[q * 4 + 3] = t1.w;
    bim[q * 4] = t2.x; bim[q * 4 + 1] = t2.y; bim[q * 4 + 2] = t2.z; bim[q * 4 + 3] = t2.w;
  }
  const float* su = WSP(float, O_SU) + ((long)b * 2048 + c * 64) * 256 + g * 16;
  float xr = 0.f, xi = 0.f;
  float uvs[16];
#pragma unroll
  for (int t4 = 0; t4 < 16; ++t4) uvs[t4] = su[(long)(t4 * 4 + (lane >> 4)) * 256 + (lane & 15)];
#pragma unroll
  for (int t4 = 0; t4 < 16; ++t4) {
    float uv = uvs[t4];
#pragma unroll
    for (int tt = 0; tt < 4; ++tt) {
      f32x2_t bu2 = {0.f, 0.f}, bu3 = {0.f, 0.f};
#pragma unroll
      for (int q = 0; q < 16; q += 4) {
        float u0 = __int_as_float(__builtin_amdgcn_readlane(__float_as_int(uv), tt * 16 + q));
        float u1 = __int_as_float(__builtin_amdgcn_readlane(__float_as_int(uv), tt * 16 + q + 1));
        float u2 = __int_as_float(__builtin_amdgcn_readlane(__float_as_int(uv), tt * 16 + q + 2));
        float u3 = __int_as_float(__builtin_amdgcn_readlane(__float_as_int(uv), tt * 16 + q + 3));
        bu2 = __builtin_elementwise_fma(f32x2_t{bre[q], bim[q]}, f32x2_t{u0, u0}, bu2);
        bu3 = __builtin_elementwise_fma(f32x2_t{bre[q + 1], bim[q + 1]}, f32x2_t{u1, u1}, bu3);
        bu2 = __builtin_elementwise_fma(f32x2_t{bre[q + 2], bim[q + 2]}, f32x2_t{u2, u2}, bu2);
        bu3 = __builtin_elementwise_fma(f32x2_t{bre[q + 3], bim[q + 3]}, f32x2_t{u3, u3}, bu3);
      }
      bu2 += bu3;
      float nr = are * xr - aim * xi + bu2.x;
      float ni = are * xi + aim * xr + bu2.y;
      xr = nr; xi = ni;
    }
  }
  WSP(float2, O_S5E)[(long)u * 64 + lane] = float2{xr, xi};
}

__device__ void item_s5_out(PP p, int l, int id, u16* smem) {
  const int lane = ltid() & 63, wave = ltid() >> 6, lr = lane & 15, lq = lane >> 4;
  const int u = id * 4 + wave;
  const int c = u & 31, g = (u >> 5) & 15, b = u >> 9;
  const float* sp = WSP(float, O_S5P + l * SZ_S5P);
  const int gn = g * 64 + lane;
  const float are = sp[gn], aim = sp[1024 + gn], aLr = sp[2048 + gn], aLi = sp[3072 + gn];
  float bre[16], bim[16];
#pragma unroll
  for (int q = 0; q < 4; ++q) {
    float4 t1 = *(const float4*)(sp + 4096 + gn * 16 + q * 4);
    float4 t2 = *(const float4*)(sp + 4096 + 16384 + gn * 16 + q * 4);
    bre[q * 4] = t1.x; bre[q * 4 + 1] = t1.y; bre[q * 4 + 2] = t1.z; bre[q * 4 + 3] = t1.w;
    bim[q * 4] = t2.x; bim[q * 4 + 1] = t2.y; bim[q * 4 + 2] = t2.z; bim[q * 4 + 3] = t2.w;
  }
  float xr = 0.f, xi = 0.f;
  const float2* e = WSP(float2, O_S5E) + (long)(u - c) * 64 + lane;
#pragma unroll 8
  for (int cc = 0; cc < c; ++cc) {
    float2 ev = e[(long)cc * 64];
    float nr = aLr * xr - aLi * xi + ev.x;
    float ni = aLr * xi + aLi * xr + ev.y;
    xr = nr; xi = ni;
  }
  bf16x8 cm[4];
#pragma unroll
  for (int ks = 0; ks < 4; ++ks) {
    const float* cp = (ks < 2 ? p->s5_cre : p->s5_cim) + (long)l * 16384 + (long)(g * 16 + lr) * 64 + (ks & 1) * 32 + lq * 8;
    float4 c0 = *(const float4*)cp, c1 = *(const float4*)(cp + 4);
    float sg = ks < 2 ? 1.f : -1.f;
    union { unsigned w[4]; bf16x8 v; } pk;
    pk.w[0] = pack2(sg * c0.x, sg * c0.y); pk.w[1] = pack2(sg * c0.z, sg * c0.w);
    pk.w[2] = pack2(sg * c1.x, sg * c1.y); pk.w[3] = pack2(sg * c1.z, sg * c1.w);
    cm[ks] = pk.v;
  }
  const float dsk = p->s5_d[l * 256 + g * 16 + lr];
  u16* X = smem + wave * 16 * 144;
  const long tok0 = (long)b * 2048 + c * 64;
  const float* su = WSP(float, O_SU) + tok0 * 256 + g * 16;
  u16* yg = WSP(u16, O_YG) + tok0 * 256 + g * 16;
  float uall[16];
#pragma unroll
  for (int t4 = 0; t4 < 16; ++t4) uall[t4] = su[(long)(t4 * 4 + (lane >> 4)) * 256 + (lane & 15)];
#pragma unroll
  for (int sub = 0; sub < 4; ++sub) {
    float ue[4];
#pragma unroll
    for (int j = 0; j < 4; ++j) ue[j] = su[(long)(sub * 16 + lq * 4 + j) * 256 + lr];
    __builtin_amdgcn_wave_barrier();
#pragma unroll
    for (int t4 = 0; t4 < 4; ++t4) {
      float uv = uall[sub * 4 + t4];
#pragma unroll
      for (int tt = 0; tt < 4; ++tt) {
        f32x2_t bu2 = {0.f, 0.f}, bu3 = {0.f, 0.f};
#pragma unroll
        for (int q = 0; q < 16; q += 4) {
          float u0 = __int_as_float(__builtin_amdgcn_readlane(__float_as_int(uv), tt * 16 + q));
          float u1 = __int_as_float(__builtin_amdgcn_readlane(__float_as_int(uv), tt * 16 + q + 1));
          float u2 = __int_as_float(__builtin_amdgcn_readlane(__float_as_int(uv), tt * 16 + q + 2));
          float u3 = __int_as_float(__builtin_amdgcn_readlane(__float_as_int(uv), tt * 16 + q + 3));
          bu2 = __builtin_elementwise_fma(f32x2_t{bre[q], bim[q]}, f32x2_t{u0, u0}, bu2);
          bu3 = __builtin_elementwise_fma(f32x2_t{bre[q + 1], bim[q + 1]}, f32x2_t{u1, u1}, bu3);
          bu2 = __builtin_elementwise_fma(f32x2_t{bre[q + 2], bim[q + 2]}, f32x2_t{u2, u2}, bu2);
          bu3 = __builtin_elementwise_fma(f32x2_t{bre[q + 3], bim[q + 3]}, f32x2_t{u3, u3}, bu3);
        }
        bu2 += bu3;
        float nr = are * xr - aim * xi + bu2.x;
        float ni = are * xi + aim * xr + bu2.y;
        xr = nr; xi = ni;
        X[(t4 * 4 + tt) * 144 + lane] = f2bf(xr);
        X[(t4 * 4 + tt) * 144 + 64 + lane] = f2bf(xi);
      }
    }
    __builtin_amdgcn_wave_barrier();
    f32x4 y = {0.f, 0.f, 0.f, 0.f};
#pragma unroll
    for (int ks = 0; ks < 4; ++ks) {
      bf16x8 xa = *(const bf16x8*)(X + lr * 144 + ks * 32 + lq * 8);
      y = mfma16(xa, cm[ks], y);
    }
#pragma unroll
    for (int j = 0; j < 4; ++j) {
      int tl = sub * 16 + lq * 4 + j;
      yg[(long)tl * 256 + lr] = f2bf(gelu(y[j] + dsk * ue[j]));
    }
  }
}

__device__ void item_memkv(PP p, int u, u16* smem) {
  const int wave = ltid() >> 6, wr = wave >> 1, wc = wave & 1;
  f32x4 acc[4][4];
#pragma unroll
  for (int i = 0; i < 4; ++i)
#pragma unroll
    for (int j = 0; j < 4; ++j) acc[i][j] = f32x4{0.f, 0.f, 0.f, 0.f};
  int ll = u >> 6; u &= 63; int rt = u >> 2, ct = u & 3;
  gemm_core(acc, WSP(u16, O_MEMH) + ((long)ll * 2048 + rt * 128) * 1024, 1024, WSP(u16, O_WKVT + ll * SZ_WKVT) + (long)ct * 128 * 1024, 1024, 1024, smem);
  int bb = rt >> 1, m0 = (rt & 1) * 128 + wr * 64, cc = ct * 2 + wc;
  u16* dst = WSP(u16, cc < 4 ? O_MEMK : O_MEMV) + (long)ll * 8 * 4 * 256 * 64 + ((long)((bb * 4 + (cc & 3)) * 256 + m0)) * 64;
  store_tile_bf16<0>(acc, dst, 64, smem);
}

__device__ void phase2(PP p, int l, u16* smem, int* shi, int rep) {
  const bool g_dry = rep > 0;
  unsigned* ctr = WSP(unsigned, O_CTR) + l * 8 + 0 + rep * 16;
  const int wave = ltid() >> 6, wr = wave >> 1, wc = wave & 1, lane = ltid() & 63, lr = lane & 15;
  int it = blockIdx.x;
  for (;;) {
    p = getP();
    const int nkv = l == 0 ? 128 : 0;
    if (it >= 32 + nkv + 1024 + 1024) break;
    do {
    if (it >= 32 && it < 32 + nkv) { if (rep == 0) item_memkv(p, it - 32, smem); continue; }
    if (it >= 32) it -= nkv;
    if (it < 32) {
      if (!PON(rep, 1)) continue;
      int kv = it >> 4, bb = (it >> 1) & 7, ct = it & 1;
      f32x4 acc[4][4];
#pragma unroll
      for (int i = 0; i < 4; ++i)
#pragma unroll
        for (int j = 0; j < 4; ++j) acc[i][j] = f32x4{0.f, 0.f, 0.f, 0.f};
      gemm_core(acc, WSP(u16, kv ? O_VC : O_KC) + (long)bb * 2048 * 64, 1024, WSP(u16, O_W1T + l * SZ_W1T) + ((long)kv * 256 + ct * 128) * 2048, 2048, 2048, smem);
      const float* bpe = WSP(float, O_BPE) + (l * 2 + kv) * 16 * 256 + ct * 128 + wc * 64;
#pragma unroll
      for (int ni = 0; ni < 4; ++ni) {
        float bv = 0.f;
#pragma unroll
        for (int kc = 0; kc < 16; ++kc) bv += bpe[kc * 256 + ni * 16 + lr];
#pragma unroll
        for (int mi = 0; mi < 4; ++mi)
#pragma unroll
          for (int j = 0; j < 4; ++j) acc[mi][ni][j] += bv;
      }
      store_tile_bf16<2>(acc, WSP(u16, O_CHID) + ((long)kv * 1024 + bb * 128 + wr * 64) * 256 + ct * 128 + wc * 64, 256, smem);
    } else if (((it - 32) & 1) == 0) {
      if (PON(rep, 2)) item_diff(p, l, (it - 32) >> 1, smem, g_dry);
    } else {
      if (PON(rep, 4)) item_s5_local(p, l, (it - 32) >> 1);
    }
    } while (0);
    it = (int)gridDim.x + fetch_item(ctr, shi);
  }
}

__device__ void phase3(PP p, int l, u16* smem, int* shi, int rep) {
  const bool g_dry = rep > 0;
  const int wave = ltid() >> 6, wr = wave >> 1, wc = wave & 1;
  const int G = gridDim.x;
  for (int it = blockIdx.x; it < 16; it += G) {
    p = getP();
    int kv = it >> 3, bb = it & 7;
    f32x4 acc[4][4];
#pragma unroll
    for (int i = 0; i < 4; ++i)
#pragma unroll
      for (int j = 0; j < 4; ++j) acc[i][j] = f32x4{0.f, 0.f, 0.f, 0.f};
    gemm_core(acc, WSP(u16, O_CHID) + ((long)kv * 1024 + bb * 128) * 256, 256, WSP(u16, O_W2T + l * SZ_W2T) + (long)kv * 128 * 256, 256, 256, smem);
    if (wc == 0) store_tile_bf16<0>(acc, WSP(u16, kv ? O_VCMP : O_KCMP) + ((long)bb * 128 + wr * 64) * 64, 64, smem);
    __syncthreads();
  }
  const int rot = ((blockIdx.x >> 8) & 1) ? 3 : 0;
  for (int r0 = 0; r0 < 6; ++r0) {
    int r = r0 + rot; if (r >= 6) r -= 6;
    for (int it = blockIdx.x; it < (r == 2 ? 512 : (r == 0 || r == 4 ? 1024 / 2 : 512)); it += G) {
      p = getP();
      __syncthreads();
      if (r == 0) { if (PON(rep, 8)) item_s5_out(p, l, it, smem); }
      else if (r == 4) { if (PON(rep, 8)) item_s5_out(p, l, 512 + it, smem); }
      else if (r == 2) { if (PON(rep, 4)) item_mem(p, l, it, smem, g_dry); }
      else { if (PON(rep, 2)) item_dilated(p, ((r - 1) >> 1) * 512 + it, smem); }
    }
  }
  __syncthreads();
}

__device__ void phase4(PP p, int l, u16* smem, int* shi, float* imp, unsigned* selm, float* resp, int rep) {
  const bool g_dry = rep > 0;
  auto dil_combine = [&](int chunk) {
  for (long i = (long)chunk * 1024 + ltid(); i < (long)(chunk + 1) * 1024; i += 256) {
    long t = i >> 5; int h = (int)(i >> 3) & 3, dc = (int)i & 7;
    float l0 = WSP(float, O_DLSE)[t * 4 + h], l1 = WSP(float, O_DLSE)[(long)T * 4 + t * 4 + h], l2 = WSP(float, O_DLSE)[(long)2 * T * 4 + t * 4 + h];
    float mx = fmaxf(l0, fmaxf(l1, l2));
    float w0 = __expf(l0 - mx), w1 = __expf(l1 - mx), w2 = __expf(l2 - mx);
    float inv = 1.f / (w0 + w1 + w2);
    w0 *= inv; w1 *= inv; w2 *= inv;
    long off = t * 256 + h * 64 + dc * 8;
    uint4 a0 = *(const uint4*)(WSP(u16, O_DILO) + off), a1 = *(const uint4*)(WSP(u16, O_DILO) + (long)T * 256 + off), a2 = *(const uint4*)(WSP(u16, O_DILO) + (long)2 * T * 256 + off);
    u16* zb = WSP(u16, O_SZ) + (long)1 * T * 256 + off;
    uint4 zz = *(const uint4*)zb;
    uint4 ov;
    auto mixw = [&](unsigned x0, unsigned x1, unsigned x2, unsigned z) {
      float lo = (w0 * bf2f((u16)(x0 & 0xffff)) + w1 * bf2f((u16)(x1 & 0xffff)) + w2 * bf2f((u16)(x2 & 0xffff))) * bf2f((u16)(z & 0xffff));
      float hi = (w0 * bf2f((u16)(x0 >> 16)) + w1 * bf2f((u16)(x1 >> 16)) + w2 * bf2f((u16)(x2 >> 16))) * bf2f((u16)(z >> 16));
      return pack2(lo, hi);
    };
    ov.x = mixw(a0.x, a1.x, a2.x, zz.x); ov.y = mixw(a0.y, a1.y, a2.y, zz.y);
    ov.z = mixw(a0.z, a1.z, a2.z, zz.z); ov.w = mixw(a0.w, a1.w, a2.w, zz.w);
    if (!g_dry) *(uint4*)zb = ov;
  }
  };
  unsigned* ctr = WSP(unsigned, O_CTR) + l * 8 + 2 + rep * 16;
  const int lane = ltid() & 63, wave = ltid() >> 6, wr = wave >> 1, wc = wave & 1, lr = lane & 15, lq = lane >> 4;
  int it = blockIdx.x;
  for (;;) {
    p = getP();
    constexpr int NNSA = 8 * 2048 / (NSA_NQT * 16);
    if (it >= NNSA + 512 + 512) break;
    if (it >= NNSA + 512) { if (PON(rep, 1)) dil_combine(it - NNSA - 512); it = (int)gridDim.x + fetch_item(ctr, shi); continue; }
    do {
    if (it < NNSA) {
      if (PON(rep, 2)) item_nsa<NSA_NQT>(p, it, smem, imp, selm, resp, g_dry);
    } else {
      if (!PON(rep, 4)) continue;
      int u = it - NNSA; int rt = u >> 2, ct = u & 3;
      f32x4 acc[4][4];
#pragma unroll
      for (int i = 0; i < 4; ++i)
#pragma unroll
        for (int j = 0; j < 4; ++j) acc[i][j] = f32x4{0.f, 0.f, 0.f, 0.f};
      gemm_core(acc, WSP(u16, O_YG) + (long)rt * 128 * 256, 256, WSP(u16, O_WGT + l * SZ_WGT) + (long)ct * 128 * 256, 256, 256, smem);
      const int cbase = (ct * 128 + wc * 64) >> 1;
      u16* zb = WSP(u16, O_SZ) + (long)2 * T * 256 + ((long)rt * 128 + wr * 64) * 256 + cbase;
      u16* patch = smem + wave * (64 * 40);
#pragma unroll
      for (int nn = 0; nn < 2; ++nn) {
        int ch = cbase + nn * 16 + lr;
        float bv = p->b_glu[l * 512 + ch], bg = p->b_glu[l * 512 + 256 + ch];
#pragma unroll
        for (int mi = 0; mi < 4; ++mi)
#pragma unroll
          for (int j = 0; j < 4; ++j)
            patch[(mi * 16 + lq * 4 + j) * 40 + nn * 16 + lr] = f2bf((acc[mi][2 * nn][j] + bv) * sigm(acc[mi][2 * nn + 1][j] + bg));
      }
      __builtin_amdgcn_wave_barrier();
#pragma unroll
      for (int i = 0; i < 4; ++i) {
        const int row = i * 16 + (lane >> 2), c8 = (lane & 3) * 8;
        u32x4 pv = *(const u32x4*)(patch + row * 40 + c8);
        u32x4 zz = *(const u32x4*)(zb + (long)row * 256 + c8);
        u32x4 ov;
#pragma unroll
        for (int k = 0; k < 4; ++k)
          ov[k] = pack2(bf2f((u16)(pv[k] & 0xffff)) * bf2f((u16)(zz[k] & 0xffff)), bf2f((u16)(pv[k] >> 16)) * bf2f((u16)(zz[k] >> 16)));
        if (!g_dry) *(u32x4*)(zb + (long)row * 256 + c8) = ov;
      }
      __builtin_amdgcn_wave_barrier();
    }
    } while (0);
    it = (int)gridDim.x + fetch_item(ctr, shi);
  }
}

__device__ void phase5(PP p, int l, u16* smem, unsigned* priv) {
  for (int t = blockIdx.x; t < 1024; t += gridDim.x) {
    p = getP();
    int rt, ct;
    if (gridDim.x == 512) { const int xcd = t & 7, slot = (t >> 3) & 63, rnd = t >> 9; rt = ((rnd * 8 + xcd) << 3) + (slot >> 3); ct = slot & 7; }
    else { rt = t >> 3; ct = t & 7; }
    f32x4 mix[4][4];
#pragma unroll
    for (int i = 0; i < 4; ++i)
#pragma unroll
      for (int j = 0; j < 4; ++j) mix[i][j] = f32x4{0.f, 0.f, 0.f, 0.f};
    for (int n = 0; n < 5; ++n) {
      f32x4 acc[4][4];
#pragma unroll
      for (int i = 0; i < 4; ++i)
#pragma unroll
        for (int j = 0; j < 4; ++j) acc[i][j] = f32x4{0.f, 0.f, 0.f, 0.f};
      float bvs[4];
      {
        const int t0 = ltid(), wc0 = (t0 >> 6) & 1, lr0 = t0 & 15;
#pragma unroll
        for (int ni = 0; ni < 4; ++ni) bvs[ni] = p->b_merge[l * 5120 + n * 1024 + ct * 128 + wc0 * 64 + ni * 16 + lr0];
      }
      gemm_core<true>(acc, (const u16*)(p->ws + O_H8 + (long)rt * 128 * 1024), 512, (const u16*)(p->ws + O_WM8 + l * SZ_WM8 + ((long)n * 1024 + ct * 128) * 1024), 512, 1024, smem);
      unsigned gp[4][4];
      const int t1 = ltid(), wc1 = (t1 >> 6) & 1, lr1 = t1 & 15;
#pragma unroll
      for (int ni = 0; ni < 4; ++ni) {
        float bv = bvs[ni];
#pragma unroll
        for (int mi = 0; mi < 4; ++mi) {
          unsigned q0 = (unsigned)(sigm(acc[mi][ni][0] * 0.03125f + bv) * 255.f + 0.5f), q1 = (unsigned)(sigm(acc[mi][ni][1] * 0.03125f + bv) * 255.f + 0.5f);
          unsigned q2 = (unsigned)(sigm(acc[mi][ni][2] * 0.03125f + bv) * 255.f + 0.5f), q3 = (unsigned)(sigm(acc[mi][ni][3] * 0.03125f + bv) * 255.f + 0.5f);
          gp[mi][ni] = q0 | (q1 << 8) | (q2 << 16) | (q3 << 24);
          acc[mi][ni] = f32x4{0.f, 0.f, 0.f, 0.f};
        }
      }
      gemm_core(acc, WSP(u16, O_SZ) + (long)n * T * 256 + (long)rt * 128 * 256, 256, WSP(u16, O_WBT + l * SZ_WBT) + ((long)n * 1024 + ct * 128) * 256, 256, 256, smem);
#pragma unroll
      for (int mi = 0; mi < 4; ++mi)
#pragma unroll
        for (int ni = 0; ni < 4; ++ni) {
          unsigned g0 = gp[mi][ni];
          mix[mi][ni][0] += (float)(g0 & 0xffu) * (1.f / 255.f) * acc[mi][ni][0];
          mix[mi][ni][1] += (float)((g0 >> 8) & 0xffu) * (1.f / 255.f) * acc[mi][ni][1];
          mix[mi][ni][2] += (float)((g0 >> 16) & 0xffu) * (1.f / 255.f) * acc[mi][ni][2];
          mix[mi][ni][3] += (float)(g0 >> 24) * (1.f / 255.f) * acc[mi][ni][3];
        }
    }
    const int t2 = ltid(), wr2 = t2 >> 7, wc2 = (t2 >> 6) & 1;
    store_tile_bf16<0>(mix, WSP(u16, O_MIXED) + ((long)rt * 128 + wr2 * 64) * 1024 + ct * 128 + wc2 * 64, 1024, smem);
  }
}

__device__ void phase6(PP p, int l, u16* smem) {
  const int lane = ltid() & 63, wave = ltid() >> 6, wr = wave >> 1, wc = wave & 1, lr = lane & 15, lq = lane >> 4;
  const float* xin = l == 0 ? p->x : p->out;
  for (int t = blockIdx.x; t < 1024; t += gridDim.x) {
    p = getP();
    int rt, ct;
    if (gridDim.x == 512) { const int xcd = t & 7, slot = (t >> 3) & 63, rnd = t >> 9; rt = ((rnd * 8 + xcd) << 3) + (slot >> 3); ct = slot & 7; }
    else { rt = t >> 3; ct = t & 7; }
    f32x4 acc[4][4];
#pragma unroll
    for (int i = 0; i < 4; ++i)
#pragma unroll
      for (int j = 0; j < 4; ++j) acc[i][j] = f32x4{0.f, 0.f, 0.f, 0.f};
    gemm_core(acc, WSP(u16, O_MIXED) + (long)rt * 128 * 1024, 1024, WSP(u16, O_WOT + l * SZ_WOT) + (long)ct * 128 * 1024, 1024, 1024, smem);
    const int t6 = ltid(), wr6 = t6 >> 7, wc6 = (t6 >> 6) & 1;
    const long base = ((long)rt * 128 + wr6 * 64) * 1024 + ct * 128 + wc6 * 64;
    store_tile_f32(acc, p->out + base, xin + base, 1024, smem);
  }
}

__device__ void phase7(PP p, int l) {
  const int wave = ltid() >> 6;
  for (int r0 = blockIdx.x * 4 + wave; r0 < T; r0 += gridDim.x * 16) {
#pragma unroll
    for (int u = 0; u < 4; ++u) {
      const int r = r0 + u * (int)gridDim.x * 4;
      if (r < T) {
        if (l == 0) rmsnorm_row<true>(p->out + (long)r * 1024, p->norm_g + 1024, WSP(u16, O_H) + (long)r * 1024, (unsigned char*)(p->ws + O_H8) + (long)r * 1024);
        else rmsnorm_row<false>(p->out + (long)r * 1024, p->final_g, p->out + (long)r * 1024);
      }
    }
  }
}

#ifndef REP_P0
#define REP_P0 1
#endif
#ifndef REP_P1
#define REP_P1 1
#endif

#define XB_TMO      128
#define XB_XCNT(j)  (256  + 64 * (j))
#define XB_XSUB(j)  (1280 + 64 * (j))
#define XB_XGEN(j)  (2304 + 64 * (j))
#define XB_TOP      3328
#define XB_TOPGEN   3392
#define XCD_BAR_WORDS 3456
#define XB_SPIN_CAP (1u << 18)
#define LAS __attribute__((address_space(3)))
__device__ __forceinline__ unsigned xb_ld(unsigned* q) { return __hip_atomic_load(q, __ATOMIC_RELAXED, __HIP_MEMORY_SCOPE_AGENT); }
__device__ __forceinline__ unsigned xb_add(unsigned* q, unsigned v) { return __hip_atomic_fetch_add(q, v, __ATOMIC_RELAXED, __HIP_MEMORY_SCOPE_AGENT); }
__device__ __forceinline__ unsigned xb_xcc_id() { return (unsigned)__builtin_amdgcn_s_getreg((3 << 11) | 20) & 0xFu; }
#define XB_SPIN(cond, bar) do { unsigned _sp = 0; while (cond) { __builtin_amdgcn_s_sleep(1); \
    if ((++_sp & 255u) == 0u) { if (xb_ld(&(bar)[XB_TMO])) break; if (_sp > XB_SPIN_CAP) { atomicAdd(&(bar)[XB_TMO], 1u); break; } } } } while (0)
struct XcdBarrier { unsigned* bar; unsigned x; volatile LAS unsigned* st; };
__device__ __forceinline__ XcdBarrier xcd_barrier_post(unsigned* bar, volatile LAS unsigned* st) {
  XcdBarrier b; b.bar = bar; b.x = xb_xcc_id(); b.st = st;
  if (threadIdx.x == 0) (void)xb_add(&bar[XB_XCNT(b.x)], 1u);
  return b;
}
__device__ __forceinline__ void xcd_barrier_complete(unsigned* bar, unsigned x, unsigned& nloc, unsigned& nx) {
  const unsigned G = gridDim.x * gridDim.y * gridDim.z;
  unsigned sum, cnt, mine, sp = 0u;
  for (;;) {
    sum = 0u; cnt = 0u; mine = 0u;
#pragma unroll
    for (unsigned j = 0; j < 16; ++j) { const unsigned c = xb_ld(&bar[XB_XCNT(j)]); sum += c; cnt += (c > 0u) ? 1u : 0u; mine = (j == x) ? c : mine; }
    if (sum == G) break;
    __builtin_amdgcn_s_sleep(1);
    if ((++sp & 255u) == 0u) { if (xb_ld(&bar[XB_TMO])) break; if (sp > XB_SPIN_CAP) { atomicAdd(&bar[XB_TMO], 1u); break; } }
  }
  nloc = mine > 0u ? mine : 1u; nx = cnt > 0u ? cnt : 1u;
}
__device__ __forceinline__ void xcd_barrier(volatile LAS unsigned* stw) {
  XcdBarrier b;
  b.bar = (unsigned*)(getP()->ws + O_BAR);
  b.x = xb_xcc_id();
  asm volatile("" : "+s"(b.x));
  b.st = stw;
  asm volatile("s_waitcnt vmcnt(0)" ::: "memory");
  __syncthreads();
  if (threadIdx.x == 0) {
    unsigned* bar = b.bar;
    __builtin_amdgcn_s_waitcnt(0);
    unsigned nloc = b.st[0], nx = b.st[1];
    if (nloc == 0u) { xcd_barrier_complete(bar, b.x, nloc, nx); b.st[0] = nloc; b.st[1] = nx; }
    const unsigned old = xb_add(&bar[XB_XSUB(b.x)], 1u);
    const unsigned gen = old / nloc;
    if (old + 1u == (gen + 1u) * nloc) {
      __builtin_amdgcn_fence(__ATOMIC_RELEASE, "agent");
      asm volatile("s_waitcnt vmcnt(0)" ::: "memory");
      const unsigned og = xb_add(&bar[XB_TOP], 1u);
      const unsigned tg = og / nx;
      if (og + 1u == (tg + 1u) * nx) xb_add(&bar[XB_TOPGEN], 1u);
      else XB_SPIN(xb_ld(&bar[XB_TOPGEN]) == tg, bar);
      __builtin_amdgcn_fence(__ATOMIC_ACQUIRE, "agent");
      xb_add(&bar[XB_XGEN(b.x)], 1u);
      asm volatile("s_waitcnt vmcnt(0)" ::: "memory");
    } else {
      XB_SPIN(xb_ld(&bar[XB_XGEN(b.x)]) == gen, bar);
      __builtin_amdgcn_fence(__ATOMIC_ACQUIRE, "agent");
      asm volatile("s_waitcnt vmcnt(0)" ::: "memory");
    }
  }
  __syncthreads();
}

#ifndef REP_P2
#define REP_P2 1
#endif
#ifndef REP_P3
#define REP_P3 1
#endif
#ifndef REP_P4
#define REP_P4 1
#endif
#ifndef REP_P5
#define REP_P5 1
#endif
#ifndef REP_P6
#define REP_P6 1
#endif
__device__ __forceinline__ int nrep(int n) { asm volatile("" : "+s"(n)); return n; }
__global__ void __launch_bounds__(256, 2) mixer_megakernel(P p_unused) {
  cg::grid_group grid = cg::this_grid();
  __shared__ __attribute__((aligned(16))) char smem_raw[73728 + 4224 + 128 + 32];
  unsigned* priv = (unsigned*)(smem_raw + 40960);
  float* imp = (float*)(smem_raw + 73728);
  unsigned* selm = (unsigned*)(smem_raw + 73728 + 4224);
  int& shi = *(int*)(smem_raw + 73728 + 4224 + 128);
  u16* smem = (u16*)smem_raw;
  {
    unsigned* stw = (unsigned*)(smem_raw + 73728 + 4224 + 128 + 16);
    if (threadIdx.x == 0) { stw[0] = 0u; stw[1] = 0u; }
    __syncthreads();
  }
  PP p0 = getP();
  volatile LAS unsigned* xbst = (volatile LAS unsigned*)(smem_raw + 73728 + 4224 + 128 + 16);
  (void)xcd_barrier_post((unsigned*)(p0->ws + O_BAR), xbst);
  if (p0->ws == nullptr) grid.sync();
  for (int rep = 0, n = nrep(REP_P0); rep < n; ++rep) phase_setup(getP(), smem_raw);
  xcd_barrier(xbst);
  for (int l = 0; l < 2; ++l) {
    for (int rep = 0, n = nrep(REP_P1); rep < n; ++rep) phase_gemm1(getP(), l, smem);
    xcd_barrier(xbst);
    for (int rep = nrep(REP_P2) - 1; rep >= 0; --rep) phase2(getP(), l, smem, &shi, rep);
    xcd_barrier(xbst);
    for (int rep = nrep(REP_P3) - 1; rep >= 0; --rep) phase3(getP(), l, smem, &shi, rep);
    xcd_barrier(xbst);
    for (int rep = nrep(REP_P4) - 1; rep >= 0; --rep) phase4(getP(), l, smem, &shi, imp, selm, (float*)priv, rep);
    xcd_barrier(xbst);
    for (int rep = 0, n = nrep(REP_P5); rep < n; ++rep) phase5(getP(), l, smem, priv);
    xcd_barrier(xbst);
    for (int rep = 0, n = nrep(l == 0 ? REP_P6 : 1); rep < n; ++rep) phase6(getP(), l, smem);
    xcd_barrier(xbst);
    phase7(getP(), l);
    if (l == 0) xcd_barrier(xbst);
  }
}

extern "C" void kernel_launch(void* const* d_in, const int* in_sizes, int n_in, void* d_out, int out_size, void* d_ws,
                              size_t ws_size, hipStream_t stream) {
  static int grid_blocks = 0;
  if (!grid_blocks) {
    int dev = 0, cus = 0, per = 0;
    hipGetDevice(&dev);
    hipDeviceGetAttribute(&cus, hipDeviceAttributeMultiprocessorCount, dev);
    hipOccupancyMaxActiveBlocksPerMultiprocessor(&per, mixer_megakernel, 256, 0);
    if (per > 2) per = 2;
    if (per < 1) per = 1;
    grid_blocks = cus * per;
  }
  if (ws_size < WS_NEED) fprintf(stderr, "workspace too small: %zu < %zu\n", ws_size, (size_t)WS_NEED);
  P hp{};
  const float** pp = (const float**)&hp;
  for (int i = 0; i < 26; ++i) pp[i] = (const float*)d_in[i];
  hp.out = (float*)d_out;
  hp.ws = (char*)d_ws;
  hipMemsetAsync((char*)d_ws + O_BAR, 0, 16384, stream);
  void* args[] = {&hp};
  hipError_t e = hipLaunchCooperativeKernel((void*)mixer_megakernel, dim3(grid_blocks), dim3(256), args, 0, stream);
  if (e != hipSuccess) fprintf(stderr, "cooperative launch failed: %s (grid %d)\n", hipGetErrorString(e), grid_blocks);
}
```
